# Optimizing an MI355X kernel written in HIP

```python
import jax, jax.numpy as jnp
from jax import lax
import numpy as np

D_MODEL = 1024
BATCH = 2
SEQ = 8192
DEPTH = 4
DEC_BATCH = 128
DEC_SEQ = 4
PAST_LEN = 8192
PAGE_SIZE = 128

MIX_WIDTH = D_MODEL
HEAD_DIM = 64
RET_HEADS = 4
RET_V = MIX_WIDTH // 4 // RET_HEADS
RET_QK = RET_V // 2
RET_THETA = 10000.0
HG_HEADS = 4
HG_V = MIX_WIDTH // 4 // HG_HEADS
HG_K = HG_V
SWA_HD = HEAD_DIM
SWA_HEADS = (MIX_WIDTH // 2) // SWA_HD
SWA_KV = 2
SWA_GROUP = SWA_HEADS // SWA_KV
WINDOW = 128
SWA_BUF = WINDOW
ROT_DIM = SWA_HD // 4
ROPE_THETA = 500000.0
CHUNK = 128
D_FF = 4 * D_MODEL
ALPHA = (2.0 * DEPTH) ** 0.25
BETA = (8.0 * DEPTH) ** -0.25
LN_EPS = 1e-5
RMS_EPS = 1e-6

IN_SPLITS = (RET_HEADS * RET_QK, RET_HEADS * RET_QK, RET_HEADS * RET_V, RET_HEADS * RET_V,
             HG_HEADS * HG_K, HG_HEADS * HG_K, HG_HEADS * HG_V, HG_HEADS * HG_V,
             SWA_HEADS * SWA_HD, SWA_KV * SWA_HD, SWA_KV * SWA_HD)
HEAD_SHAPES = ((RET_HEADS, RET_QK), (RET_HEADS, RET_QK), (RET_HEADS, RET_V), (RET_HEADS, RET_V),
               (HG_HEADS, HG_K), (HG_HEADS, HG_K), (HG_HEADS, HG_V), (HG_HEADS, HG_V),
               (SWA_HEADS, SWA_HD), (SWA_KV, SWA_HD), (SWA_KV, SWA_HD))
V_PARTS = (2, 6, 10)
IN_COLS = sum(IN_SPLITS)

kernel_name = 'hymba_retention_hgrn2_swa_deepnorm_step'


def _layernorm(x, g, b):
    xf = x.astype(jnp.float32)
    mu = jnp.mean(xf, -1, keepdims=True)
    var = jnp.mean(jnp.square(xf - mu), -1, keepdims=True)
    return ((xf - mu) * lax.rsqrt(var + LN_EPS) * g.astype(jnp.float32) + b.astype(jnp.float32)).astype(x.dtype)


def _rmsnorm(x):
    xf = x.astype(jnp.float32)
    return xf * lax.rsqrt(jnp.mean(jnp.square(xf), -1, keepdims=True) + RMS_EPS)


def _rope(x, pos, inv_freq):
    r = 2 * inv_freq.shape[0]
    ang = pos.astype(jnp.float32)[:, None] * inv_freq[None, :]
    cos = jnp.cos(ang)[:, None, :]
    sin = jnp.sin(ang)[:, None, :]
    xr = x[..., :r].astype(jnp.float32)
    x1, x2 = xr[..., :r // 2], xr[..., r // 2:]
    rot = jnp.concatenate([x1 * cos - x2 * sin, x2 * cos + x1 * sin], -1).astype(x.dtype)
    return jnp.concatenate([rot, x[..., r:]], -1)


def _project(x, w_in):
    n, l = x.shape[:2]
    h = jnp.einsum('nld,dc->nlc', x, w_in)
    offs = [int(o) for o in np.cumsum(IN_SPLITS)[:-1]]
    parts = jnp.split(h, offs, axis=-1)
    return [p.reshape(n, l, *hs) for p, hs in zip(parts, HEAD_SHAPES)]


def _ret_log_decay():
    return jnp.log(1.0 - 2.0 ** (-5.0 - jnp.arange(RET_HEADS, dtype=jnp.float32)))


def _ret_qk(rq, rk, pos):
    inv = RET_THETA ** (-jnp.linspace(0.0, 1.0, RET_QK // 2, dtype=jnp.float32))
    return _rope(rq, pos, inv), _rope(rk, pos, inv) * (RET_QK ** -0.5)


def _swa_rope(x, pos):
    inv = ROPE_THETA ** (-jnp.arange(0, ROT_DIM, 2, dtype=jnp.float32) / ROT_DIM)
    return _rope(x, pos, inv)


def _hg_gates(hf, lb):
    lb = lb.reshape(HG_HEADS, HG_K)
    logf = jnp.logaddexp(jnp.log(lb), jnp.log1p(-lb) + jax.nn.log_sigmoid(hf.astype(jnp.float32)))
    return logf, -jnp.expm1(logf)


def _ret_chunk(q, k, v, s0):
    q, k, v, s0 = (a.astype(jnp.float32) for a in (q, k, v, s0))
    L = q.shape[1]
    lg = _ret_log_decay()
    idx = jnp.arange(L, dtype=jnp.float32)
    diff = idx[:, None] - idx[None, :]
    dec = jnp.where(diff >= 0, jnp.exp(jnp.maximum(diff, 0.0)[None] * lg[:, None, None]), 0.0)
    a = jnp.einsum('nthk,nshk->nhts', q, k) * dec[None]
    inter = jnp.exp((idx + 1.0)[:, None] * lg[None, :])[None, :, :, None]
    o = jnp.einsum('nhts,nshv->nthv', a, v) + jnp.einsum('nthk,nhkv->nthv', q, s0) * inter
    kdec = k * jnp.exp((L - 1.0 - idx)[:, None] * lg[None, :])[None, :, :, None]
    s = jnp.exp(L * lg)[None, :, None, None] * s0 + jnp.einsum('nshk,nshv->nhkv', kdec, v)
    return o, s


def _hg_chunk(q, k, v, logf, s0):
    q, k, v, s0 = (a.astype(jnp.float32) for a in (q, k, v, s0))
    L = q.shape[1]
    b = jnp.cumsum(logf, axis=1)
    causal = jnp.tril(jnp.ones((L, L), dtype=bool))
    rel = b[:, :, None] - b[:, None, :]
    dec = jnp.where(causal[None, :, :, None, None], jnp.exp(jnp.minimum(rel, 0.0)), 0.0)
    a = jnp.einsum('nthk,nshk,ntshk->nhts', q, k, dec)
    o = jnp.einsum('nhts,nshv->nthv', a, v) + jnp.einsum('nthk,nhkv->nthv', q * jnp.exp(b), s0)
    bl = b[:, -1]
    s = jnp.exp(bl)[..., None] * s0 + jnp.einsum('nshk,nshv->nhkv', k * jnp.exp(bl[:, None] - b), v)
    return o, s


def _scan_chunks(chunk_fn, arrays, s0):
    n, S = arrays[0].shape[:2]
    nc = S // CHUNK
    xs = tuple(jnp.moveaxis(a.reshape(n, nc, CHUNK, *a.shape[2:]), 1, 0) for a in arrays)

    def step(s, c):
        o, s = chunk_fn(*c, s)
        return s, o

    s, o = lax.scan(step, s0, xs)
    o = jnp.moveaxis(o, 0, 1)
    return o.reshape(n, S, *o.shape[3:]), s


def _sink_attn(q, k, v, mask, sinks):
    s = jnp.einsum('nmqkgd,nmskd->nmkgqs', q, k).astype(jnp.float32) * (SWA_HD ** -0.5)
    s = jnp.where(mask[None, :, None, None], s, -jnp.inf)
    sink = sinks.astype(jnp.float32).reshape(SWA_KV, SWA_GROUP)[None, None, :, :, None, None]
    m = jnp.maximum(jnp.max(s, -1, keepdims=True), sink)
    p = jnp.exp(s - m)
    den = jnp.sum(p, -1, keepdims=True) + jnp.exp(sink - m)
    o = jnp.einsum('nmkgqs,nmskd->nmqkgd', p / den, v.astype(jnp.float32))
    n, mb, lq = o.shape[:3]
    return o.reshape(n, mb * lq, SWA_HEADS * SWA_HD)


def _swa_prompt(q, k, v, sinks):
    n, S = q.shape[:2]
    nb = S // WINDOW
    qb = q.reshape(n, nb, WINDOW, SWA_KV, SWA_GROUP, SWA_HD)
    kb = k.reshape(n, nb, WINDOW, SWA_KV, SWA_HD)
    vb = v.reshape(n, nb, WINDOW, SWA_KV, SWA_HD)
    pad = ((0, 0), (1, 0), (0, 0), (0, 0), (0, 0))
    kk = jnp.concatenate([jnp.pad(kb, pad)[:, :-1], kb], axis=2)
    vv = jnp.concatenate([jnp.pad(vb, pad)[:, :-1], vb], axis=2)
    blk = jnp.arange(nb)[:, None]
    qpos = blk * WINDOW + jnp.arange(WINDOW)[None, :]
    kpos = (blk - 1) * WINDOW + jnp.arange(2 * WINDOW)[None, :]
    d = qpos[:, :, None] - kpos[:, None, :]
    mask = (d >= 0) & (d <= WINDOW) & (kpos[:, None, :] >= 0)
    return _sink_attn(qb, kk, vv, mask, sinks)


def _swa_sample(q, k, v, ck, cv, sinks):
    n, L = q.shape[:2]
    kk = jnp.concatenate([ck.astype(k.dtype), k], axis=1)
    vv = jnp.concatenate([cv.astype(v.dtype), v], axis=1)
    qpos = PAST_LEN + jnp.arange(L)
    kpos = PAST_LEN - SWA_BUF + jnp.arange(SWA_BUF + L)
    d = qpos[:, None] - kpos[None, :]
    mask = ((d >= 0) & (d <= WINDOW))[None]
    o = _sink_attn(q.reshape(n, 1, L, SWA_KV, SWA_GROUP, SWA_HD), kk[:, None], vv[:, None], mask, sinks)
    return o, kk[:, -SWA_BUF:], vv[:, -SWA_BUF:]


def _merge(o_r, g_r, o_h, g_h, o_s, hg_norm_w, w_out, dtype):
    n, l = o_r.shape[:2]
    ret = _rmsnorm(o_r) * jax.nn.silu(g_r.astype(jnp.float32))
    hg = _rmsnorm(o_h) * hg_norm_w.astype(jnp.float32) * jax.nn.silu(g_h.astype(jnp.float32))
    cat = jnp.concatenate([ret.reshape(n, l, -1), hg.reshape(n, l, -1),
                           o_s.astype(jnp.float32)], -1).astype(dtype)
    return jnp.einsum('nlc,cd->nld', cat, w_out)


def _mix_prompt(x, w_in, w_out, sinks, lb, hg_norm_w):
    n, S = x.shape[:2]
    pos = jnp.arange(S)
    rq, rk, rv, rg, hq, hf, hi, hgt, sq, sk, sv = _project(x, w_in)
    q_r, k_r = _ret_qk(rq, rk, pos)
    o_r, st_r = _scan_chunks(_ret_chunk, (q_r, k_r, rv), jnp.zeros((n, RET_HEADS, RET_QK, RET_V), jnp.float32))
    logf, k_h = _hg_gates(hf, lb)
    o_h, st_h = _scan_chunks(_hg_chunk, (hq, k_h, hi, logf), jnp.zeros((n, HG_HEADS, HG_K, HG_V), jnp.float32))
    q_s, k_s = _swa_rope(sq, pos), _swa_rope(sk, pos)
    o_s = _swa_prompt(q_s, k_s, sv, sinks)
    m = _merge(o_r, rg, o_h, hgt, o_s, hg_norm_w, w_out, x.dtype)
    return m, st_r, st_h, k_s[:, -SWA_BUF:], sv[:, -SWA_BUF:]


def _mix_sample(x, s_r, s_h, ck, cv, w_in, w_out, sinks, lb, hg_norm_w):
    L = x.shape[1]
    pos = PAST_LEN + jnp.arange(L)
    rq, rk, rv, rg, hq, hf, hi, hgt, sq, sk, sv = _project(x, w_in)
    q_r, k_r = _ret_qk(rq, rk, pos)
    o_r, st_r = _ret_chunk(q_r, k_r, rv, s_r)
    logf, k_h = _hg_gates(hf, lb)
    o_h, st_h = _hg_chunk(hq, k_h, hi, logf, s_h)
    q_s, k_s = _swa_rope(sq, pos), _swa_rope(sk, pos)
    o_s, nk, nv = _swa_sample(q_s, k_s, sv, ck, cv, sinks)
    m = _merge(o_r, rg, o_h, hgt, o_s, hg_norm_w, w_out, x.dtype)
    return m, st_r, st_h, nk, nv


def _post_block(x, mix, g1, b1, w_up, w_down, g2, b2):
    x = _layernorm(ALPHA * x + mix, g1, b1)
    h = jax.nn.relu(jnp.einsum('nld,df->nlf', x, w_up))
    return _layernorm(ALPHA * x + jnp.einsum('nlf,fd->nld', h * h, w_down), g2, b2)


def setup_inputs(seed: int = 0) -> dict:
    key = jax.random.key(seed)
    ks = jax.random.split(key, 20)
    nrm = jax.random.normal
    col_scale = jnp.concatenate([jnp.full((c,), BETA if i in V_PARTS else 1.0, jnp.float32)
                                 for i, c in enumerate(IN_SPLITS)])
    return {
        'x_prompt': nrm(ks[0], (BATCH, SEQ, D_MODEL), jnp.float32),
        'x_sample': nrm(ks[1], (DEC_BATCH, DEC_SEQ, D_MODEL), jnp.float32),
        'state_ret': 0.5 * nrm(ks[2], (DEPTH, DEC_BATCH, RET_HEADS, RET_QK, RET_V), jnp.float32),
        'state_hgrn': 0.5 * nrm(ks[3], (DEPTH, DEC_BATCH, HG_HEADS, HG_K, HG_V), jnp.float32),
        'cache_swa_k': nrm(ks[4], (DEPTH, DEC_BATCH, SWA_BUF, SWA_KV, SWA_HD), jnp.float32),
        'cache_swa_v': nrm(ks[5], (DEPTH, DEC_BATCH, SWA_BUF, SWA_KV, SWA_HD), jnp.float32),
        'w_in': nrm(ks[6], (DEPTH, D_MODEL, IN_COLS), jnp.float32) * (D_MODEL ** -0.5) * col_scale,
        'w_out': nrm(ks[7], (DEPTH, MIX_WIDTH, D_MODEL), jnp.float32) * (MIX_WIDTH ** -0.5) * BETA,
        'swa_sinks': 0.5 * nrm(ks[8], (DEPTH, SWA_HEADS), jnp.float32),
        'hg_lb_raw': 0.1 * nrm(ks[9], (DEPTH, HG_HEADS * HG_K), jnp.float32),
        'hg_norm_w': 1.0 + 0.1 * nrm(ks[10], (DEPTH, HG_V), jnp.float32),
        'ln_mix_g': 1.0 + 0.1 * nrm(ks[11], (DEPTH, D_MODEL), jnp.float32),
        'ln_mix_b': 0.1 * nrm(ks[12], (DEPTH, D_MODEL), jnp.float32),
        'w_up': nrm(ks[13], (DEPTH, D_MODEL, D_FF), jnp.float32) * (D_MODEL ** -0.5),
        'w_down': nrm(ks[14], (DEPTH, D_FF, D_MODEL), jnp.float32) * (D_FF ** -0.5) * BETA,
        'ln_ffn_g': 1.0 + 0.1 * nrm(ks[15], (DEPTH, D_MODEL), jnp.float32),
        'ln_ffn_b': 0.1 * nrm(ks[16], (DEPTH, D_MODEL), jnp.float32),
    }


def reference(x_prompt, x_sample, state_ret, state_hgrn, cache_swa_k, cache_swa_v,
              w_in, w_out, swa_sinks, hg_lb_raw, hg_norm_w, ln_mix_g, ln_mix_b,
              w_up, w_down, ln_ffn_g, ln_ffn_b):
    lb_all = jnp.cumsum(jax.nn.softmax(hg_lb_raw.astype(jnp.float32), axis=0), axis=0)
    lb = lb_all - lb_all[0:1]
    xp, xs = x_prompt, x_sample
    p_r, p_h, p_k, p_v = [], [], [], []
    s_r, s_h, s_k, s_v = [], [], [], []
    for l in range(DEPTH):
        m, a, b, c, d = _mix_prompt(xp, w_in[l], w_out[l], swa_sinks[l], lb[l], hg_norm_w[l])
        xp = _post_block(xp, m, ln_mix_g[l], ln_mix_b[l], w_up[l], w_down[l], ln_ffn_g[l], ln_ffn_b[l])
        p_r.append(a); p_h.append(b); p_k.append(c); p_v.append(d)
        m, a, b, c, d = _mix_sample(xs, state_ret[l], state_hgrn[l], cache_swa_k[l], cache_swa_v[l],
                                    w_in[l], w_out[l], swa_sinks[l], lb[l], hg_norm_w[l])
        xs = _post_block(xs, m, ln_mix_g[l], ln_mix_b[l], w_up[l], w_down[l], ln_ffn_g[l], ln_ffn_b[l])
        s_r.append(a); s_h.append(b); s_k.append(c); s_v.append(d)
    return (xp, xs, jnp.stack(p_r), jnp.stack(p_h), jnp.stack(p_k), jnp.stack(p_v),
            jnp.stack(s_r), jnp.stack(s_h), jnp.stack(s_k), jnp.stack(s_v))
```

```cpp
#include <hip/hip_runtime.h>
#include <hip/hip_cooperative_groups.h>
#include <cstdio>
namespace cg = cooperative_groups;

typedef unsigned short bf16_t;
typedef short bf16x8 __attribute__((ext_vector_type(8)));
typedef float f32x4 __attribute__((ext_vector_type(4)));
typedef unsigned u32x4 __attribute__((ext_vector_type(4)));
typedef unsigned u32x2 __attribute__((ext_vector_type(2)));

constexpr int NT = 512;
constexpr int DM = 1024, TP = 16384, TS = 512, TT = 16896, SEQ = 8192, NIN = 2560, DFF = 4096;
constexpr int C_RQ = 0, C_RK = 128, C_RV = 256, C_RG = 512, C_HQ = 768, C_HF = 1024, C_HI = 1280, C_HG = 1536, C_SQ = 1792, C_SK = 2304, C_SV = 2432;
constexpr float ALPHA = 1.6817928305074290f;
constexpr size_t O_YP = 0, O_YS = 16777216, O_PR = 17301504, O_PH = 17367040, O_PK = 17498112, O_PV = 17629184,
                 O_SR = 17760256, O_SH = 21954560, O_SK = 30343168, O_SV = 38731776;
constexpr size_t WS_WIN = 0, WS_WOUT = WS_WIN + 20971520, WS_WUP = WS_WOUT + 8388608, WS_WDN = WS_WUP + 33554432,
                 WS_XB = WS_WDN + 33554432, WS_R1 = WS_XB + 34603008, WS_CAT = WS_R1 + 86507520,
                 WS_SLR = WS_R1 + 138412032, WS_SLH = WS_SLR + 4194304, WS_SIR = WS_SLH + 8388608, WS_SIH = WS_SIR + 4194304,
                 WS_DEC = WS_SIH + 8388608, WS_END = WS_DEC + 131072;
constexpr int LDS_BYTES = 108544;

struct Params {
    const float *x_prompt, *x_sample, *state_ret, *state_hgrn, *cache_k, *cache_v, *w_in, *w_out, *sinks, *lb_raw, *hg_norm_w,
                *ln_mix_g, *ln_mix_b, *w_up, *w_down, *ln_ffn_g, *ln_ffn_b;
    float* out; unsigned char* ws;
};

__device__ __forceinline__ unsigned pk2(float lo, float hi) { unsigned r; asm("v_cvt_pk_bf16_f32 %0, %1, %2" : "=v"(r) : "v"(lo), "v"(hi)); return r; }
__device__ __forceinline__ float bflo(unsigned u) { return __uint_as_float(u << 16); }
__device__ __forceinline__ float bfhi(unsigned u) { return __uint_as_float(u & 0xffff0000u); }
__device__ __forceinline__ float bf2f(bf16_t h) { return __uint_as_float((unsigned)h << 16); }
__device__ __forceinline__ bf16_t f2bf(float f) { return (bf16_t)(pk2(f, 0.f) & 0xffffu); }
__device__ __forceinline__ void unpack8(u32x4 u, float* f) { f[0] = bflo(u.x); f[1] = bfhi(u.x); f[2] = bflo(u.y); f[3] = bfhi(u.y); f[4] = bflo(u.z); f[5] = bfhi(u.z); f[6] = bflo(u.w); f[7] = bfhi(u.w); }
__device__ __forceinline__ u32x4 pack8(const float* f) { u32x4 u; u.x = pk2(f[0], f[1]); u.y = pk2(f[2], f[3]); u.z = pk2(f[4], f[5]); u.w = pk2(f[6], f[7]); return u; }
__device__ __forceinline__ bf16x8 as_bf8(u32x4 u) { return __builtin_bit_cast(bf16x8, u); }
__device__ __forceinline__ f32x4 mfma16(bf16x8 a, bf16x8 b, f32x4 c) { return __builtin_amdgcn_mfma_f32_16x16x32_bf16(a, b, c, 0, 0, 0); }
__device__ __forceinline__ void sincos_red(float a, float& s, float& c) {
    float k = rintf(a * 0.15915494309189535f);
    float r = fmaf(-k, 6.2831854820251465f, a);
    r = fmaf(k, 1.7484555e-7f, r);
    s = __sinf(r); c = __cosf(r);
}
__device__ __forceinline__ float ret_inv(int i) { return exp2f(-(float)i * 0.88584749f); }
__device__ __forceinline__ float swa_inv(int i) { return exp2f(-(float)i * 2.36644607f); }
__device__ __forceinline__ float ret_lg(int h) { return logf(1.0f - exp2f(-5.0f - (float)h)); }
__device__ __forceinline__ float lb_val(const float* raw, int l, int col) {
    float r0 = raw[col], r1 = raw[256 + col], r2 = raw[512 + col], r3 = raw[768 + col];
    float m = fmaxf(fmaxf(r0, r1), fmaxf(r2, r3));
    float e0 = expf(r0 - m), e1 = expf(r1 - m), e2 = expf(r2 - m), e3 = expf(r3 - m);
    float s = e0 + e1 + e2 + e3, a = 0.f;
    if (l >= 1) a += e1; if (l >= 2) a += e2; if (l >= 3) a += e3;
    return a / s;
}
__device__ __forceinline__ int otid() { int t = threadIdx.x; asm volatile("" : "+v"(t)); return t; }
__device__ __forceinline__ float silu(float g) { return g / (1.0f + expf(-g)); }

__device__ void transpose_convert(unsigned char* lds, const float* __restrict__ W, bf16_t* __restrict__ Wt, int K, int N) {
    float* tile = (float*)lds;
    const int tid = otid(), tn = N / 64, nt = (K / 64) * tn;
    for (int u = blockIdx.x; u < nt; u += gridDim.x) {
        const int k0 = (u / tn) * 64, n0 = (u % tn) * 64;
        __syncthreads();
#pragma unroll
        for (int i = 0; i < 2; ++i) { const int idx = tid + i * 512, r = idx >> 4, c4 = (idx & 15) * 4;
            const float4 v = *(const float4*)(W + (size_t)(k0 + r) * N + n0 + c4);
            tile[r * 65 + c4] = v.x; tile[r * 65 + c4 + 1] = v.y; tile[r * 65 + c4 + 2] = v.z; tile[r * 65 + c4 + 3] = v.w; }
        __syncthreads();
        const int n = tid >> 3, kk = (tid & 7) * 8; float f[8];
#pragma unroll
        for (int j = 0; j < 8; ++j) f[j] = tile[(kk + j) * 65 + n];
        *(u32x4*)(Wt + (size_t)(n0 + n) * K + k0 + kk) = pack8(f);
    }
}
__device__ void prep_phase(unsigned char* lds, const Params& p) {
    for (int l = 0; l < 4; ++l) {
        transpose_convert(lds, p.w_in + (size_t)l * DM * NIN, (bf16_t*)(p.ws + WS_WIN) + (size_t)l * NIN * DM, DM, NIN);
        transpose_convert(lds, p.w_out + (size_t)l * DM * DM, (bf16_t*)(p.ws + WS_WOUT) + (size_t)l * DM * DM, DM, DM);
        transpose_convert(lds, p.w_up + (size_t)l * DM * DFF, (bf16_t*)(p.ws + WS_WUP) + (size_t)l * DFF * DM, DM, DFF);
        transpose_convert(lds, p.w_down + (size_t)l * DFF * DM, (bf16_t*)(p.ws + WS_WDN) + (size_t)l * DM * DFF, DFF, DM);
    }
    float* X = p.out; bf16_t* Xb = (bf16_t*)(p.ws + WS_XB);
    const size_t n4 = (size_t)TT * DM / 4, np4 = (size_t)TP * DM / 4;
    for (size_t i = (size_t)blockIdx.x * NT + threadIdx.x; i < n4; i += (size_t)gridDim.x * NT) {
        const float4 v = (i < np4) ? ((const float4*)p.x_prompt)[i] : ((const float4*)p.x_sample)[i - np4];
        ((float4*)X)[i] = v; u32x2 w; w.x = pk2(v.x, v.y); w.y = pk2(v.z, v.w); ((u32x2*)Xb)[i] = w;
    }
}

struct EpiH { bf16_t* H; __device__ __forceinline__ void operator()(int row, int col, f32x4 v) const { u32x2 w; w.x = pk2(v[0], v[1]); w.y = pk2(v[2], v[3]); *(u32x2*)(H + (size_t)row * NIN + col) = w; } };
struct EpiRes { float* X; __device__ __forceinline__ void operator()(int row, int col, f32x4 v) const { f32x4* q = (f32x4*)(X + (size_t)row * DM + col); *q = *q * ALPHA + v; } };
struct EpiRelu2 { bf16_t* HF; __device__ __forceinline__ void operator()(int row, int col, f32x4 v) const { u32x2 w; float a = fmaxf(v[0], 0.f), b = fmaxf(v[1], 0.f), c = fmaxf(v[2], 0.f), d = fmaxf(v[3], 0.f); w.x = pk2(a * a, b * b); w.y = pk2(c * c, d * d); *(u32x2*)(HF + (size_t)row * DFF + col) = w; } };

template <class Epi>
__device__ void gemm_phase(unsigned char* lds, const bf16_t* __restrict__ A, const bf16_t* __restrict__ Bt, int M, int N, int K, const Epi& epi) {
    constexpr int BM = 256, BN = 128, BK = 64, LS = 72;
    bf16_t* sA = (bf16_t*)lds; bf16_t* sB = sA + BM * LS;
    const int tid = otid(), lane = tid & 63, wid = tid >> 6, fr = lane & 15, g = lane >> 4, wr = wid >> 1, wc = wid & 1;
    const int nN = N / BN, units = (M / BM) * nN;
    for (int u = blockIdx.x; u < units; u += gridDim.x) {
        const int pm = u / nN, pn = u % nN;
        const bf16_t* Ab = A + (size_t)pm * BM * K; const bf16_t* Bb = Bt + (size_t)pn * BN * K;
        f32x4 acc[4][4];
#pragma unroll
        for (int a = 0; a < 4; ++a)
#pragma unroll
            for (int b = 0; b < 4; ++b) acc[a][b] = (f32x4){0.f, 0.f, 0.f, 0.f};
        u32x4 ra[4], rb[2];
#pragma unroll
        for (int i = 0; i < 4; ++i) { const int idx = tid + i * 512; ra[i] = *(const u32x4*)(Ab + (size_t)(idx >> 3) * K + (idx & 7) * 8); }
#pragma unroll
        for (int i = 0; i < 2; ++i) { const int idx = tid + i * 512; rb[i] = *(const u32x4*)(Bb + (size_t)(idx >> 3) * K + (idx & 7) * 8); }
        for (int k0 = 0; k0 < K; k0 += BK) {
            __syncthreads();
#pragma unroll
            for (int i = 0; i < 4; ++i) { const int idx = tid + i * 512; *(u32x4*)(sA + (idx >> 3) * LS + (idx & 7) * 8) = ra[i]; }
#pragma unroll
            for (int i = 0; i < 2; ++i) { const int idx = tid + i * 512; *(u32x4*)(sB + (idx >> 3) * LS + (idx & 7) * 8) = rb[i]; }
            __syncthreads();
            if (k0 + BK < K) {
#pragma unroll
                for (int i = 0; i < 4; ++i) { const int idx = tid + i * 512; ra[i] = *(const u32x4*)(Ab + (size_t)(idx >> 3) * K + k0 + BK + (idx & 7) * 8); }
#pragma unroll
                for (int i = 0; i < 2; ++i) { const int idx = tid + i * 512; rb[i] = *(const u32x4*)(Bb + (size_t)(idx >> 3) * K + k0 + BK + (idx & 7) * 8); }
            }
#pragma unroll
            for (int ks = 0; ks < 2; ++ks) {
                bf16x8 af[4], bfr[4];
#pragma unroll
                for (int m = 0; m < 4; ++m) af[m] = *(const bf16x8*)(sA + (wr * 64 + m * 16 + fr) * LS + ks * 32 + g * 8);
#pragma unroll
                for (int n = 0; n < 4; ++n) bfr[n] = *(const bf16x8*)(sB + (wc * 64 + n * 16 + fr) * LS + ks * 32 + g * 8);
#pragma unroll
                for (int m = 0; m < 4; ++m)
#pragma unroll
                    for (int n = 0; n < 4; ++n) acc[m][n] = mfma16(bfr[n], af[m], acc[m][n]);
            }
        }
#pragma unroll
        for (int m = 0; m < 4; ++m)
#pragma unroll
            for (int n = 0; n < 4; ++n) epi(pm * BM + wr * 64 + m * 16 + fr, pn * BN + wc * 64 + n * 16 + g * 4, acc[m][n]);
    }
}

__device__ void ln_phase(float* X, bf16_t* Xb, const float* __restrict__ gam, const float* __restrict__ bet) {
    const int lane = threadIdx.x & 63, wid = threadIdx.x >> 6;
    for (int row = blockIdx.x * 8 + wid; row < TT; row += gridDim.x * 8) {
        f32x4 v[4]; float s = 0.f;
#pragma unroll
        for (int i = 0; i < 4; ++i) { v[i] = *(const f32x4*)(X + (size_t)row * DM + i * 256 + lane * 4); s += (v[i][0] + v[i][1]) + (v[i][2] + v[i][3]); }
#pragma unroll
        for (int o = 1; o < 64; o <<= 1) s += __shfl_xor(s, o);
        const float mu = s * (1.0f / 1024.0f); float q = 0.f;
#pragma unroll
        for (int i = 0; i < 4; ++i) { const f32x4 d = v[i] - mu; q += (d[0] * d[0] + d[1] * d[1]) + (d[2] * d[2] + d[3] * d[3]); }
#pragma unroll
        for (int o = 1; o < 64; o <<= 1) q += __shfl_xor(q, o);
        const float rstd = rsqrtf(q * (1.0f / 1024.0f) + 1e-5f);
#pragma unroll
        for (int i = 0; i < 4; ++i) { const int c = i * 256 + lane * 4; const f32x4 gg = *(const f32x4*)(gam + c), bb = *(const f32x4*)(bet + c);
            const f32x4 o = (v[i] - mu) * rstd * gg + bb; *(f32x4*)(X + (size_t)row * DM + c) = o;
            u32x2 w; w.x = pk2(o[0], o[1]); w.y = pk2(o[2], o[3]); *(u32x2*)(Xb + (size_t)row * DM + c) = w; }
    }
}

constexpr int QS = 72, BS = 68, VS = 136;
template <int DK, bool WITH_Q>
__device__ void stage_chunk(unsigned char* lds, const Params& p, int l, int n, int h, int c) {
    constexpr bool HG = (DK == 64);
    bf16_t* sQ = (bf16_t*)lds; bf16_t* sK = (bf16_t*)(lds + 18432); float* sB = (float*)(lds + 36864); bf16_t* sVt = (bf16_t*)(lds + 71680); float* sTot = (float*)(lds + 106496);
    const bf16_t* H = (const bf16_t*)(p.ws + WS_R1);
    const int tid = otid(); const int row0 = n * SEQ + c * 128;
    if (HG) {
#pragma unroll
        for (int i = 0; i < 2; ++i) { const int idx = tid + i * 512, t = idx >> 3, dg = idx & 7; const bf16_t* hr = H + (size_t)(row0 + t) * NIN;
            float hf[8], kk[8]; unpack8(*(const u32x4*)(hr + C_HF + h * 64 + dg * 8), hf);
#pragma unroll
            for (int j = 0; j < 8; ++j) { const float lb = lb_val(p.lb_raw, l, h * 64 + dg * 8 + j); const float k = (1.0f - lb) / (1.0f + expf(hf[j])); kk[j] = k; sB[t * BS + dg * 8 + j] = log1pf(-k); }
            *(u32x4*)(sK + t * QS + dg * 8) = pack8(kk);
            if (WITH_Q) *(u32x4*)(sQ + t * QS + dg * 8) = *(const u32x4*)(hr + C_HQ + h * 64 + dg * 8);
            float vv[8]; unpack8(*(const u32x4*)(hr + C_HI + h * 64 + dg * 8), vv);
#pragma unroll
            for (int j = 0; j < 8; ++j) sVt[(dg * 8 + j) * VS + t] = f2bf(vv[j]);
        }
        __syncthreads();
        { const int d = tid & 63, seg = tid >> 6; float a = 0.f;
#pragma unroll
          for (int j = 0; j < 16; ++j) { a += sB[(seg * 16 + j) * BS + d]; sB[(seg * 16 + j) * BS + d] = a; }
          sTot[seg * 64 + d] = a;
          __syncthreads();
          float off = 0.f;
          for (int s2 = 0; s2 < seg; ++s2) off += sTot[s2 * 64 + d];
          if (seg > 0) {
#pragma unroll
              for (int j = 0; j < 16; ++j) sB[(seg * 16 + j) * BS + d] += off; }
        }
    } else {
        const float lg = ret_lg(h);
        if (tid < 256) { const int t = tid >> 1, ig = tid & 1; const bf16_t* hr = H + (size_t)(row0 + t) * NIN; const float pos = (float)(c * 128 + t);
            float k1[8], k2[8], o1[8], o2[8], cs[8], sn[8];
#pragma unroll
            for (int j = 0; j < 8; ++j) sincos_red(pos * ret_inv(ig * 8 + j), sn[j], cs[j]);
            unpack8(*(const u32x4*)(hr + C_RK + h * 32 + ig * 8), k1); unpack8(*(const u32x4*)(hr + C_RK + h * 32 + 16 + ig * 8), k2);
#pragma unroll
            for (int j = 0; j < 8; ++j) { o1[j] = (k1[j] * cs[j] - k2[j] * sn[j]) * 0.17677669529663687f; o2[j] = (k2[j] * cs[j] + k1[j] * sn[j]) * 0.17677669529663687f; }
            *(u32x4*)(sK + t * QS + ig * 8) = pack8(o1); *(u32x4*)(sK + t * QS + 16 + ig * 8) = pack8(o2);
            if (WITH_Q) {
                unpack8(*(const u32x4*)(hr + C_RQ + h * 32 + ig * 8), k1); unpack8(*(const u32x4*)(hr + C_RQ + h * 32 + 16 + ig * 8), k2);
#pragma unroll
                for (int j = 0; j < 8; ++j) { o1[j] = k1[j] * cs[j] - k2[j] * sn[j]; o2[j] = k2[j] * cs[j] + k1[j] * sn[j]; }
                *(u32x4*)(sQ + t * QS + ig * 8) = pack8(o1); *(u32x4*)(sQ + t * QS + 16 + ig * 8) = pack8(o2);
            }
        }
#pragma unroll
        for (int i = 0; i < 8; ++i) { const int idx = tid + i * 512, t = idx >> 5, d = idx & 31; sB[t * BS + d] = (float)(t + 1) * lg; }
#pragma unroll
        for (int i = 0; i < 2; ++i) { const int idx = tid + i * 512, t = idx >> 3, dg = idx & 7; const bf16_t* hr = H + (size_t)(row0 + t) * NIN;
            float vv[8]; unpack8(*(const u32x4*)(hr + C_RV + h * 64 + dg * 8), vv);
#pragma unroll
            for (int j = 0; j < 8; ++j) sVt[(dg * 8 + j) * VS + t] = f2bf(vv[j]);
        }
    }
    __syncthreads();
}

template <int DK>
__device__ void local_state_item(unsigned char* lds, const Params& p, int l, int n, int h, int c) {
    constexpr bool HG = (DK == 64);
    bf16_t* sK = (bf16_t*)(lds + 18432); float* sB = (float*)(lds + 36864); bf16_t* sVt = (bf16_t*)(lds + 71680); bf16_t* sKt = (bf16_t*)(lds + 89088);
    const int tid = otid(), lane = tid & 63, wid = tid >> 6, fr = lane & 15, g = lane >> 4;
    __syncthreads();
    stage_chunk<DK, false>(lds, p, l, n, h, c);
    for (int idx = tid; idx < 128 * DK / 8; idx += 512) { const int t = idx / (DK / 8), dg = idx % (DK / 8);
        float kk[8]; unpack8(*(const u32x4*)(sK + t * QS + dg * 8), kk);
#pragma unroll
        for (int j = 0; j < 8; ++j) { const int d = dg * 8 + j; sKt[d * VS + t] = f2bf(kk[j] * expf(sB[127 * BS + d] - sB[t * BS + d])); }
    }
    const int ci = (n * 4 + h) * 64 + c;
    if (HG && tid < 64) ((float*)(p.ws + WS_DEC))[ci * 64 + tid] = expf(sB[127 * BS + tid]);
    __syncthreads();
    float* Sl = (float*)(p.ws + (HG ? WS_SLH : WS_SLR)) + (size_t)ci * DK * 64;
    constexpr int NTILE = HG ? 2 : 1;
#pragma unroll
    for (int tt = 0; tt < NTILE; ++tt) {
        const int dt = HG ? (wid >> 1) : (wid >> 2), vt = HG ? ((wid & 1) * 2 + tt) : (wid & 3);
        f32x4 acc = (f32x4){0.f, 0.f, 0.f, 0.f};
#pragma unroll
        for (int ks = 0; ks < 4; ++ks) {
            const bf16x8 a = *(const bf16x8*)(sKt + (dt * 16 + fr) * VS + ks * 32 + g * 8);
            const bf16x8 b = *(const bf16x8*)(sVt + (vt * 16 + fr) * VS + ks * 32 + g * 8);
            acc = mfma16(a, b, acc);
        }
#pragma unroll
        for (int j = 0; j < 4; ++j) Sl[(dt * 16 + g * 4 + j) * 64 + vt * 16 + fr] = acc[j];
    }
}

__device__ void scan_phase(const Params& p, int l) {
    const int gt = blockIdx.x * NT + otid();
    if (gt < 32768 + 16384) {
        const bool hg = gt < 32768; const int g2 = hg ? gt : gt - 32768;
        const int esz = hg ? 4096 : 2048, ch = hg ? (g2 >> 12) : (g2 >> 11), e = g2 & (esz - 1);
        const float* Sl = (const float*)(p.ws + (hg ? WS_SLH : WS_SLR)) + (size_t)ch * 64 * esz + e;
        float* Si = (float*)(p.ws + (hg ? WS_SIH : WS_SIR)) + (size_t)ch * 64 * esz + e;
        const float* dec = (const float*)(p.ws + WS_DEC) + (size_t)ch * 64 * 64 + (e >> 6);
        const float dc = expf(128.0f * ret_lg(ch & 3));
        float S = 0.f;
#pragma unroll 1
        for (int c0 = 0; c0 < 64; c0 += 8) { float sl[8], dd[8];
#pragma unroll
            for (int j = 0; j < 8; ++j) { sl[j] = Sl[(size_t)j * esz]; dd[j] = hg ? dec[j * 64] : dc; }
#pragma unroll
            for (int j = 0; j < 8; ++j) { Si[(size_t)j * esz] = S; S = dd[j] * S + sl[j]; }
            Sl += (size_t)8 * esz; Si += (size_t)8 * esz; dec += 8 * 64; }
        p.out[(hg ? O_PH : O_PR) + (size_t)(l * 8 + ch) * esz + e] = S;
    }
}

template <int DK>
__device__ void chunk_out_item(unsigned char* lds, const Params& p, int l, int n, int h, int c) {
    constexpr bool HG = (DK == 64); constexpr int NKS = DK / 32;
    bf16_t* sQ = (bf16_t*)lds; bf16_t* sK = (bf16_t*)(lds + 18432); float* sB = (float*)(lds + 36864); bf16_t* sVt = (bf16_t*)(lds + 71680); bf16_t* sS0 = (bf16_t*)(lds + 89088);
    const bf16_t* H = (const bf16_t*)(p.ws + WS_R1); bf16_t* CAT = (bf16_t*)(p.ws + WS_CAT);
    const int tid = otid(), lane = tid & 63, wid = tid >> 6, fr = lane & 15, g = lane >> 4;
    __syncthreads();
    const int ci = (n * 4 + h) * 64 + c;
    { const float* Si = (const float*)(p.ws + (HG ? WS_SIH : WS_SIR)) + (size_t)ci * DK * 64;
      for (int idx = tid; idx < DK * 64; idx += 512) { const int d = idx >> 6, v = idx & 63; sS0[v * QS + d] = f2bf(Si[idx]); } }
    stage_chunk<DK, true>(lds, p, l, n, h, c);
    const int i = wid, t = 16 * i + fr;
    bf16x8 qt[NKS], qh[NKS]; float r[NKS][8];
#pragma unroll
    for (int ks = 0; ks < NKS; ++ks) { float q[8], a[8], b2[8]; unpack8(*(const u32x4*)(sQ + t * QS + ks * 32 + g * 8), q);
#pragma unroll
        for (int e = 0; e < 8; ++e) { const int d = ks * 32 + g * 8 + e; const float bt = sB[t * BS + d]; r[ks][e] = (i == 0) ? 0.f : sB[(16 * i - 1) * BS + d]; a[e] = q[e] * expf(bt - r[ks][e]); b2[e] = q[e] * expf(bt); }
        qt[ks] = as_bf8(pack8(a)); qh[ks] = as_bf8(pack8(b2)); }
    f32x4 acc[4];
#pragma unroll
    for (int vt = 0; vt < 4; ++vt) { acc[vt] = (f32x4){0.f, 0.f, 0.f, 0.f};
#pragma unroll
        for (int ks = 0; ks < NKS; ++ks) acc[vt] = mfma16(*(const bf16x8*)(sS0 + (vt * 16 + fr) * QS + ks * 32 + g * 8), qh[ks], acc[vt]); }
    for (int jp = 0; jp <= i; jp += 2) {
        f32x4 aT[2];
#pragma unroll
        for (int jj = 0; jj < 2; ++jj) { const int j = jp + jj; aT[jj] = (f32x4){0.f, 0.f, 0.f, 0.f};
            if (j <= i) { const int s = 16 * j + fr;
#pragma unroll
                for (int ks = 0; ks < NKS; ++ks) { float kk[8]; unpack8(*(const u32x4*)(sK + s * QS + ks * 32 + g * 8), kk);
#pragma unroll
                    for (int e = 0; e < 8; ++e) kk[e] *= expf(r[ks][e] - sB[s * BS + ks * 32 + g * 8 + e]);
                    aT[jj] = mfma16(as_bf8(pack8(kk)), qt[ks], aT[jj]); }
                if (j == i) {
#pragma unroll
                    for (int e = 0; e < 4; ++e) if (g * 4 + e > fr) aT[jj][e] = 0.f; }
            } }
        u32x4 pb; pb.x = pk2(aT[0][0], aT[0][1]); pb.y = pk2(aT[0][2], aT[0][3]); pb.z = pk2(aT[1][0], aT[1][1]); pb.w = pk2(aT[1][2], aT[1][3]);
        const int j1 = (jp + 1 <= i) ? jp + 1 : jp;
#pragma unroll
        for (int vt = 0; vt < 4; ++vt) { u32x4 av; const u32x2 a0 = *(const u32x2*)(sVt + (vt * 16 + fr) * VS + 16 * jp + g * 4), a1 = *(const u32x2*)(sVt + (vt * 16 + fr) * VS + 16 * j1 + g * 4);
            av.x = a0.x; av.y = a0.y; av.z = a1.x; av.w = a1.y; acc[vt] = mfma16(as_bf8(av), as_bf8(pb), acc[vt]); }
    }
    float ss = 0.f;
#pragma unroll
    for (int vt = 0; vt < 4; ++vt) ss += (acc[vt][0] * acc[vt][0] + acc[vt][1] * acc[vt][1]) + (acc[vt][2] * acc[vt][2] + acc[vt][3] * acc[vt][3]);
    ss += __shfl_xor(ss, 16); ss += __shfl_xor(ss, 32);
    const float rms = rsqrtf(ss * (1.0f / 64.0f) + 1e-6f);
    const int row = n * SEQ + c * 128 + t;
#pragma unroll
    for (int vt = 0; vt < 4; ++vt) { const int v0 = vt * 16 + g * 4; const u32x2 gu = *(const u32x2*)(H + (size_t)row * NIN + (HG ? C_HG : C_RG) + h * 64 + v0);
        const float g0 = bflo(gu.x), g1 = bfhi(gu.x), g2 = bflo(gu.y), g3 = bfhi(gu.y); float w0 = rms, w1 = rms, w2 = rms, w3 = rms;
        if (HG) { const f32x4 nw = *(const f32x4*)(p.hg_norm_w + l * 64 + v0); w0 *= nw[0]; w1 *= nw[1]; w2 *= nw[2]; w3 *= nw[3]; }
        u32x2 o; o.x = pk2(acc[vt][0] * w0 * silu(g0), acc[vt][1] * w1 * silu(g1)); o.y = pk2(acc[vt][2] * w2 * silu(g2), acc[vt][3] * w3 * silu(g3));
        *(u32x2*)(CAT + (size_t)row * DM + (HG ? 256 : 0) + h * 64 + v0) = o; }
}

__device__ void swa_prompt_item(unsigned char* lds, const Params& p, int l, int n, int qb, int kvh) {
    constexpr int VT = 200;
    bf16_t* sK = (bf16_t*)lds; bf16_t* sVt = (bf16_t*)(lds + 27648); bf16_t* sQ = (bf16_t*)(lds + 53248);
    const bf16_t* H = (const bf16_t*)(p.ws + WS_R1); bf16_t* CAT = (bf16_t*)(p.ws + WS_CAT);
    const int tid = otid(), lane = tid & 63, wid = tid >> 6, fr = lane & 15, g = lane >> 4;
    const int q0 = qb * 64;
    __syncthreads();
#pragma unroll
    for (int it = 0; it < 3; ++it) { const int idx = tid + it * 512, key = idx >> 3, dg = idx & 7; const int pos = q0 - 128 + key;
        const bool ok = pos >= 0; const bf16_t* hr = H + (size_t)(n * SEQ + (ok ? pos : 0)) * NIN;
        const bool wr_cache = (qb >= 126) && (key >= 128);
        float* ok_out = p.out + O_PK + ((size_t)((l * 2 + n) * 128 + (pos - (SEQ - 128))) * 2 + kvh) * 64;
        float* ov_out = p.out + O_PV + ((size_t)((l * 2 + n) * 128 + (pos - (SEQ - 128))) * 2 + kvh) * 64;
        if (dg == 0) { float x1[8], x2[8], o1[8], o2[8];
            unpack8(*(const u32x4*)(hr + C_SK + kvh * 64), x1); unpack8(*(const u32x4*)(hr + C_SK + kvh * 64 + 8), x2);
#pragma unroll
            for (int j = 0; j < 8; ++j) { float sn, cs; sincos_red((float)pos * swa_inv(j), sn, cs); o1[j] = ok ? (x1[j] * cs - x2[j] * sn) : 0.f; o2[j] = ok ? (x2[j] * cs + x1[j] * sn) : 0.f; }
            *(u32x4*)(sK + key * QS) = pack8(o1); *(u32x4*)(sK + key * QS + 8) = pack8(o2);
            if (wr_cache) {
#pragma unroll
                for (int j = 0; j < 8; ++j) { ok_out[j] = bf2f(f2bf(o1[j])); ok_out[8 + j] = bf2f(f2bf(o2[j])); } }
        } else if (dg >= 2) { u32x4 kv = *(const u32x4*)(hr + C_SK + kvh * 64 + dg * 8); if (!ok) kv = (u32x4){0u, 0u, 0u, 0u}; *(u32x4*)(sK + key * QS + dg * 8) = kv;
            if (wr_cache) { float kk[8]; unpack8(kv, kk);
#pragma unroll
                for (int j = 0; j < 8; ++j) ok_out[dg * 8 + j] = kk[j]; } }
        { float vv[8]; unpack8(*(const u32x4*)(hr + C_SV + kvh * 64 + dg * 8), vv);
#pragma unroll
          for (int j = 0; j < 8; ++j) { sVt[(dg * 8 + j) * VT + key] = ok ? f2bf(vv[j]) : (bf16_t)0; if (wr_cache) ov_out[dg * 8 + j] = vv[j]; } }
    }
#pragma unroll
    for (int it = 0; it < 4; ++it) { const int idx = tid + it * 512, rw = idx >> 3, dg = idx & 7, hh = rw >> 6, iq = rw & 63; const int pos = q0 + iq;
        const bf16_t* hr = H + (size_t)(n * SEQ + pos) * NIN + C_SQ + (kvh * 4 + hh) * 64;
        if (dg == 0) { float x1[8], x2[8], o1[8], o2[8]; unpack8(*(const u32x4*)(hr), x1); unpack8(*(const u32x4*)(hr + 8), x2);
#pragma unroll
            for (int j = 0; j < 8; ++j) { float sn, cs; sincos_red((float)pos * swa_inv(j), sn, cs); o1[j] = (x1[j] * cs - x2[j] * sn) * 0.125f; o2[j] = (x2[j] * cs + x1[j] * sn) * 0.125f; }
            *(u32x4*)(sQ + rw * QS) = pack8(o1); *(u32x4*)(sQ + rw * QS + 8) = pack8(o2);
        } else if (dg >= 2) { float x[8]; unpack8(*(const u32x4*)(hr + dg * 8), x);
#pragma unroll
            for (int j = 0; j < 8; ++j) x[j] *= 0.125f;
            *(u32x4*)(sQ + rw * QS + dg * 8) = pack8(x); }
    }
    __syncthreads();
    const int hh = wid >> 1, qh = wid & 1; const float sink = p.sinks[l * 8 + kvh * 4 + hh];
    bf16x8 bq[2][2];
#pragma unroll
    for (int qt = 0; qt < 2; ++qt)
#pragma unroll
        for (int ks = 0; ks < 2; ++ks) bq[qt][ks] = *(const bf16x8*)(sQ + (hh * 64 + 32 * qh + 16 * qt + fr) * QS + ks * 32 + g * 8);
    f32x4 sT[10][2];
#pragma unroll
    for (int kt = 0; kt < 10; ++kt) { const int krow = 16 * (2 * qh + kt) + fr;
        const bf16x8 a0 = *(const bf16x8*)(sK + krow * QS + g * 8), a1 = *(const bf16x8*)(sK + krow * QS + 32 + g * 8);
#pragma unroll
        for (int qt = 0; qt < 2; ++qt) { f32x4 z = (f32x4){0.f, 0.f, 0.f, 0.f}; z = mfma16(a0, bq[qt][0], z); z = mfma16(a1, bq[qt][1], z); sT[kt][qt] = z; } }
    float mx[2] = {-INFINITY, -INFINITY};
#pragma unroll
    for (int kt = 0; kt < 10; ++kt)
#pragma unroll
        for (int qt = 0; qt < 2; ++qt)
#pragma unroll
            for (int e = 0; e < 4; ++e) { const int j = 16 * (2 * qh + kt) + g * 4 + e, iq = 32 * qh + 16 * qt + fr; const bool valid = (j >= iq) && (j <= iq + 128) && (q0 - 128 + j >= 0);
                const float s = valid ? sT[kt][qt][e] : -INFINITY; sT[kt][qt][e] = s; mx[qt] = fmaxf(mx[qt], s); }
    float den[2];
#pragma unroll
    for (int qt = 0; qt < 2; ++qt) { float m = mx[qt]; m = fmaxf(m, __shfl_xor(m, 16)); m = fmaxf(m, __shfl_xor(m, 32)); m = fmaxf(m, sink); mx[qt] = m; den[qt] = 0.f; }
#pragma unroll
    for (int kt = 0; kt < 10; ++kt)
#pragma unroll
        for (int qt = 0; qt < 2; ++qt)
#pragma unroll
            for (int e = 0; e < 4; ++e) { const float pe = expf(sT[kt][qt][e] - mx[qt]); sT[kt][qt][e] = pe; den[qt] += pe; }
#pragma unroll
    for (int qt = 0; qt < 2; ++qt) { float d = den[qt]; d += __shfl_xor(d, 16); d += __shfl_xor(d, 32); den[qt] = 1.0f / (d + expf(sink - mx[qt])); }
    f32x4 oT[4][2];
#pragma unroll
    for (int dt = 0; dt < 4; ++dt)
#pragma unroll
        for (int qt = 0; qt < 2; ++qt) oT[dt][qt] = (f32x4){0.f, 0.f, 0.f, 0.f};
#pragma unroll
    for (int kp = 0; kp < 5; ++kp) {
        u32x4 pb[2];
#pragma unroll
        for (int qt = 0; qt < 2; ++qt) { pb[qt].x = pk2(sT[2 * kp][qt][0], sT[2 * kp][qt][1]); pb[qt].y = pk2(sT[2 * kp][qt][2], sT[2 * kp][qt][3]); pb[qt].z = pk2(sT[2 * kp + 1][qt][0], sT[2 * kp + 1][qt][1]); pb[qt].w = pk2(sT[2 * kp + 1][qt][2], sT[2 * kp + 1][qt][3]); }
        const int kb = 16 * (2 * qh + 2 * kp);
#pragma unroll
        for (int dt = 0; dt < 4; ++dt) { const u32x2 a0 = *(const u32x2*)(sVt + (dt * 16 + fr) * VT + kb + g * 4), a1 = *(const u32x2*)(sVt + (dt * 16 + fr) * VT + kb + 16 + g * 4);
            u32x4 av; av.x = a0.x; av.y = a0.y; av.z = a1.x; av.w = a1.y;
#pragma unroll
            for (int qt = 0; qt < 2; ++qt) oT[dt][qt] = mfma16(as_bf8(av), as_bf8(pb[qt]), oT[dt][qt]); }
    }
#pragma unroll
    for (int qt = 0; qt < 2; ++qt) { const int row = n * SEQ + q0 + 32 * qh + 16 * qt + fr;
#pragma unroll
        for (int dt = 0; dt < 4; ++dt) { u32x2 o; o.x = pk2(oT[dt][qt][0] * den[qt], oT[dt][qt][1] * den[qt]); o.y = pk2(oT[dt][qt][2] * den[qt], oT[dt][qt][3] * den[qt]);
            *(u32x2*)(CAT + (size_t)row * DM + 512 + (kvh * 4 + hh) * 64 + dt * 16 + g * 4) = o; } }
}

template <int DK>
__device__ void sample_rec_item(unsigned char* lds, const Params& p, int l, int n, int h) {
    constexpr bool HG = (DK == 64); constexpr int PER = DK / 8;
    float* sq = (float*)lds; float* sk = sq + 256; float* sf = sk + 256; float* sv = sf + 256; float* spart = sv + 256;
    const bf16_t* H = (const bf16_t*)(p.ws + WS_R1); bf16_t* CAT = (bf16_t*)(p.ws + WS_CAT);
    const int tid = otid(), lane = tid & 63, wid = tid >> 6; const int row0 = TP + n * 4;
    __syncthreads();
    if (HG) {
        if (tid < 256) { const int t = tid >> 6, d = tid & 63; const bf16_t* hr = H + (size_t)(row0 + t) * NIN;
            const float hf = bf2f(hr[C_HF + h * 64 + d]); const float lb = lb_val(p.lb_raw, l, h * 64 + d); const float k = (1.0f - lb) / (1.0f + expf(hf));
            sk[t * 64 + d] = k; sf[t * 64 + d] = 1.0f - k; sq[t * 64 + d] = bf2f(hr[C_HQ + h * 64 + d]); }
        else { const int t = (tid - 256) >> 6, v = tid & 63; sv[t * 64 + v] = bf2f(H[(size_t)(row0 + t) * NIN + C_HI + h * 64 + v]); }
    } else {
        const float gam = 1.0f - exp2f(-5.0f - (float)h);
        if (tid < 64) { const int t = tid >> 4, i = tid & 15; const bf16_t* hr = H + (size_t)(row0 + t) * NIN; float sn, cs; sincos_red((float)(SEQ + t) * ret_inv(i), sn, cs);
            const float q1 = bf2f(hr[C_RQ + h * 32 + i]), q2 = bf2f(hr[C_RQ + h * 32 + 16 + i]), k1 = bf2f(hr[C_RK + h * 32 + i]), k2 = bf2f(hr[C_RK + h * 32 + 16 + i]);
            sq[t * 64 + i] = q1 * cs - q2 * sn; sq[t * 64 + 16 + i] = q2 * cs + q1 * sn;
            sk[t * 64 + i] = (k1 * cs - k2 * sn) * 0.17677669529663687f; sk[t * 64 + 16 + i] = (k2 * cs + k1 * sn) * 0.17677669529663687f;
            sf[t * 64 + i] = gam; sf[t * 64 + 16 + i] = gam; }
        if (tid >= 256) { const int t = (tid - 256) >> 6, v = tid & 63; sv[t * 64 + v] = bf2f(H[(size_t)(row0 + t) * NIN + C_RV + h * 64 + v]); }
    }
    __syncthreads();
    const int v = lane, dg = wid; float S[PER];
    const float* Sin = (HG ? p.state_hgrn : p.state_ret) + ((size_t)((l * 128 + n) * 4 + h) * DK) * 64;
    float* Sout = p.out + (HG ? O_SH : O_SR) + ((size_t)((l * 128 + n) * 4 + h) * DK) * 64;
#pragma unroll
    for (int i = 0; i < PER; ++i) S[i] = Sin[(dg * PER + i) * 64 + v];
#pragma unroll
    for (int t = 0; t < 4; ++t) { float part = 0.f; const float vv = sv[t * 64 + v];
#pragma unroll
        for (int i = 0; i < PER; ++i) { const int d = dg * PER + i; S[i] = sf[t * 64 + d] * S[i] + sk[t * 64 + d] * vv; part += sq[t * 64 + d] * S[i]; }
        spart[(t * 8 + dg) * 64 + v] = part; }
#pragma unroll
    for (int i = 0; i < PER; ++i) Sout[(dg * PER + i) * 64 + v] = S[i];
    __syncthreads();
    if (tid < 256) { const int t = wid; float o = 0.f;
#pragma unroll
        for (int k = 0; k < 8; ++k) o += spart[(t * 8 + k) * 64 + v];
        float ss = o * o;
#pragma unroll
        for (int m = 1; m < 64; m <<= 1) ss += __shfl_xor(ss, m);
        const float rms = rsqrtf(ss * (1.0f / 64.0f) + 1e-6f);
        const float gt = bf2f(H[(size_t)(row0 + t) * NIN + (HG ? C_HG : C_RG) + h * 64 + v]);
        float w = rms; if (HG) w *= p.hg_norm_w[l * 64 + v];
        CAT[(size_t)(row0 + t) * DM + (HG ? 256 : 0) + h * 64 + v] = f2bf(o * w * silu(gt)); }
}

__device__ void swa_sample_item(unsigned char* lds, const Params& p, int l, int n, int kvh) {
    float* sKa = (float*)lds; float* sVa = (float*)(lds + 34320); float* sQq = (float*)(lds + 68112); float* sP = (float*)(lds + 72208);
    const bf16_t* H = (const bf16_t*)(p.ws + WS_R1); bf16_t* CAT = (bf16_t*)(p.ws + WS_CAT);
    const int tid = otid(), lane = tid & 63, wid = tid >> 6; const int row0 = TP + n * 4;
    __syncthreads();
    const size_t cbase = (size_t)(l * 128 + n) * 128 * 128;
    for (int idx = tid; idx < 128 * 64; idx += 512) { const int j = idx >> 6, d = idx & 63; sKa[j * 65 + d] = p.cache_k[cbase + (size_t)(j * 2 + kvh) * 64 + d]; sVa[j * 64 + d] = p.cache_v[cbase + (size_t)(j * 2 + kvh) * 64 + d]; }
    if (tid < 256) { const int t = tid >> 6, d = tid & 63; const bf16_t* hr = H + (size_t)(row0 + t) * NIN;
        sVa[(128 + t) * 64 + d] = bf2f(hr[C_SV + kvh * 64 + d]);
        if (d >= 16) sKa[(128 + t) * 65 + d] = bf2f(hr[C_SK + kvh * 64 + d]);
        else if (d < 8) { float sn, cs; sincos_red((float)(SEQ + t) * swa_inv(d), sn, cs); const float x1 = bf2f(hr[C_SK + kvh * 64 + d]), x2 = bf2f(hr[C_SK + kvh * 64 + 8 + d]);
            sKa[(128 + t) * 65 + d] = x1 * cs - x2 * sn; sKa[(128 + t) * 65 + 8 + d] = x2 * cs + x1 * sn; } }
    for (int idx = tid; idx < 16 * 64; idx += 512) { const int r = idx >> 6, d = idx & 63, t = r >> 2, hh = r & 3; const bf16_t* hr = H + (size_t)(row0 + t) * NIN + C_SQ + (kvh * 4 + hh) * 64;
        if (d >= 16) sQq[r * 64 + d] = bf2f(hr[d]);
        else if (d < 8) { float sn, cs; sincos_red((float)(SEQ + t) * swa_inv(d), sn, cs); const float x1 = bf2f(hr[d]), x2 = bf2f(hr[8 + d]); sQq[r * 64 + d] = x1 * cs - x2 * sn; sQq[r * 64 + 8 + d] = x2 * cs + x1 * sn; } }
    __syncthreads();
    for (int pi = tid; pi < 16 * 132; pi += 512) { const int r = pi / 132, j = pi % 132, t = r >> 2; float s = 0.f;
#pragma unroll 16
        for (int d = 0; d < 64; ++d) s += sQq[r * 64 + d] * sKa[j * 65 + d];
        sP[r * 136 + j] = (j >= t && j <= t + 128) ? s * 0.125f : -INFINITY; }
    __syncthreads();
#pragma unroll
    for (int rr = 0; rr < 2; ++rr) { const int r = wid * 2 + rr, hh = r & 3; const float sink = p.sinks[l * 8 + kvh * 4 + hh];
        const float s0 = sP[r * 136 + lane], s1 = sP[r * 136 + 64 + lane], s2 = (lane < 4) ? sP[r * 136 + 128 + lane] : -INFINITY;
        float m = fmaxf(fmaxf(s0, s1), s2);
#pragma unroll
        for (int o = 1; o < 64; o <<= 1) m = fmaxf(m, __shfl_xor(m, o));
        m = fmaxf(m, sink);
        const float p0 = expf(s0 - m), p1 = expf(s1 - m), p2 = expf(s2 - m); float dsum = p0 + p1 + p2;
#pragma unroll
        for (int o = 1; o < 64; o <<= 1) dsum += __shfl_xor(dsum, o);
        const float inv = 1.0f / (dsum + expf(sink - m));
        sP[r * 136 + lane] = p0 * inv; sP[r * 136 + 64 + lane] = p1 * inv; if (lane < 4) sP[r * 136 + 128 + lane] = p2 * inv; }
    __syncthreads();
#pragma unroll
    for (int rr = 0; rr < 2; ++rr) { const int r = wid + rr * 8, d = lane, t = r >> 2, hh = r & 3; float o = 0.f;
        for (int j = 0; j < 132; ++j) o += sP[r * 136 + j] * sVa[j * 64 + d];
        CAT[(size_t)(row0 + t) * DM + 512 + (kvh * 4 + hh) * 64 + d] = f2bf(o); }
    for (int idx = tid; idx < 128 * 64; idx += 512) { const int j = idx >> 6, d = idx & 63; const size_t o = cbase + (size_t)(j * 2 + kvh) * 64 + d;
        p.out[O_SK + o] = sKa[(j + 4) * 65 + d]; p.out[O_SV + o] = sVa[(j + 4) * 64 + d]; }
}

__device__ void mix_a_phase(unsigned char* lds, const Params& p, int l) {
    for (int it = blockIdx.x; it < 2816; it += gridDim.x) {
        if (it < 512) { swa_prompt_item(lds, p, l, it >> 8, (it >> 1) & 127, it & 1); }
        else if (it < 1536) { const int k = it - 512, ty = k >> 9, n = (k >> 8) & 1, h = (k >> 6) & 3, c = k & 63;
            if (ty == 0) local_state_item<64>(lds, p, l, n, h, c); else local_state_item<32>(lds, p, l, n, h, c); }
        else if (it < 2560) { const int k = it - 1536, ty = k >> 9, n = (k >> 2) & 127, h = k & 3;
            if (ty == 0) sample_rec_item<64>(lds, p, l, n, h); else sample_rec_item<32>(lds, p, l, n, h); }
        else { const int k = it - 2560; swa_sample_item(lds, p, l, k >> 1, k & 1); }
    }
}
__device__ void mix_c_phase(unsigned char* lds, const Params& p, int l) {
    for (int it = blockIdx.x; it < 1024; it += gridDim.x) { const int ty = it >> 9, n = (it >> 8) & 1, h = (it >> 6) & 3, c = it & 63;
        if (ty == 0) chunk_out_item<64>(lds, p, l, n, h, c); else chunk_out_item<32>(lds, p, l, n, h, c); }
}

__global__ void __launch_bounds__(NT) fwd_megakernel(Params p) {
    extern __shared__ __attribute__((aligned(16))) unsigned char lds[];
    cg::grid_group grid = cg::this_grid();
    bf16_t* Xb = (bf16_t*)(p.ws + WS_XB); bf16_t* H = (bf16_t*)(p.ws + WS_R1); bf16_t* CAT = (bf16_t*)(p.ws + WS_CAT); float* X = p.out;
    prep_phase(lds, p);
    grid.sync();
#pragma unroll 1
    for (int l = 0; l < 4; ++l) {
        gemm_phase(lds, Xb, (const bf16_t*)(p.ws + WS_WIN) + (size_t)l * NIN * DM, TT, NIN, DM, EpiH{H});
        grid.sync();
        mix_a_phase(lds, p, l);
        grid.sync();
        scan_phase(p, l);
        grid.sync();
        mix_c_phase(lds, p, l);
        grid.sync();
        gemm_phase(lds, CAT, (const bf16_t*)(p.ws + WS_WOUT) + (size_t)l * DM * DM, TT, DM, DM, EpiRes{X});
        grid.sync();
        ln_phase(X, Xb, p.ln_mix_g + l * DM, p.ln_mix_b + l * DM);
        grid.sync();
        gemm_phase(lds, Xb, (const bf16_t*)(p.ws + WS_WUP) + (size_t)l * DFF * DM, TT, DFF, DM, EpiRelu2{H});
        grid.sync();
        gemm_phase(lds, H, (const bf16_t*)(p.ws + WS_WDN) + (size_t)l * DM * DFF, TT, DM, DFF, EpiRes{X});
        grid.sync();
        ln_phase(X, Xb, p.ln_ffn_g + l * DM, p.ln_ffn_b + l * DM);
        grid.sync();
    }
}

extern "C" void kernel_launch(void* const* d_in, const int* in_sizes, int n_in, void* d_out, int out_size, void* d_ws, size_t ws_size, hipStream_t stream) {
    static int grid_blocks = 0;
    if (!grid_blocks) {
        int dev = 0, cus = 0, per_cu = 0;
        hipGetDevice(&dev);
        hipDeviceGetAttribute(&cus, hipDeviceAttributeMultiprocessorCount, dev);
        hipFuncSetAttribute((const void*)fwd_megakernel, hipFuncAttributeMaxDynamicSharedMemorySize, LDS_BYTES);
        hipOccupancyMaxActiveBlocksPerMultiprocessor(&per_cu, (const void*)fwd_megakernel, NT, LDS_BYTES);
        if (per_cu < 1) per_cu = 1;
        grid_blocks = cus * per_cu;
        if (ws_size < WS_END) fprintf(stderr, "workspace too small: %zu < %zu\n", ws_size, (size_t)WS_END);
    }
    Params p{};
    p.x_prompt = (const float*)d_in[0]; p.x_sample = (const float*)d_in[1]; p.state_ret = (const float*)d_in[2]; p.state_hgrn = (const float*)d_in[3];
    p.cache_k = (const float*)d_in[4]; p.cache_v = (const float*)d_in[5]; p.w_in = (const float*)d_in[6]; p.w_out = (const float*)d_in[7];
    p.sinks = (const float*)d_in[8]; p.lb_raw = (const float*)d_in[9]; p.hg_norm_w = (const float*)d_in[10]; p.ln_mix_g = (const float*)d_in[11];
    p.ln_mix_b = (const float*)d_in[12]; p.w_up = (const float*)d_in[13]; p.w_down = (const float*)d_in[14]; p.ln_ffn_g = (const float*)d_in[15]; p.ln_ffn_b = (const float*)d_in[16];
    p.out = (float*)d_out; p.ws = (unsigned char*)d_ws;
    void* args[] = {&p};
    hipError_t e = hipLaunchCooperativeKernel((const void*)fwd_megakernel, dim3(grid_blocks), dim3(NT), args, LDS_BYTES, stream);
    if (e != hipSuccess) fprintf(stderr, "cooperative launch failed: %s (grid %d)\n", hipGetErrorString(e), grid_blocks);
}
```

```cpp
#include <hip/hip_runtime.h>
#include <hip/hip_cooperative_groups.h>
#include <cstdio>
namespace cg = cooperative_groups;

typedef unsigned short bf16_t;
typedef short bf16x8 __attribute__((ext_vector_type(8)));
typedef float f32x4 __attribute__((ext_vector_type(4)));
typedef unsigned u32x4 __attribute__((ext_vector_type(4)));
typedef unsigned u32x2 __attribute__((ext_vector_type(2)));

constexpr int NT = 512;
constexpr int DM = 1024, TP = 16384, TS = 512, TT = 16896, SEQ = 8192, NIN = 2560, DFF = 4096;
constexpr int C_RQ = 0, C_RK = 128, C_RV = 256, C_RG = 512, C_HQ = 768, C_HF = 1024, C_HI = 1280, C_HG = 1536, C_SQ = 1792, C_SK = 2304, C_SV = 2432;
constexpr float ALPHA = 1.6817928305074290f;
constexpr size_t O_YP = 0, O_YS = 16777216, O_PR = 17301504, O_PH = 17367040, O_PK = 17498112, O_PV = 17629184,
                 O_SR = 17760256, O_SH = 21954560, O_SK = 30343168, O_SV = 38731776;
constexpr size_t WS_WIN = 0, WS_WOUT = WS_WIN + 20971520, WS_WUP = WS_WOUT + 8388608, WS_WDN = WS_WUP + 33554432,
                 WS_XB = WS_WDN + 33554432, WS_R1 = WS_XB + 34603008, WS_CAT = WS_R1 + 86507520,
                 WS_SLR = WS_R1 + 138412032, WS_SLH = WS_SLR + 4194304, WS_SIR = WS_SLH + 8388608, WS_SIH = WS_SIR + 4194304,
                 WS_DEC = WS_SIH + 8388608, WS_END = WS_DEC + 131072;
constexpr int LDS_BYTES = 131072;

struct Params {
    const float *x_prompt, *x_sample, *state_ret, *state_hgrn, *cache_k, *cache_v, *w_in, *w_out, *sinks, *lb_raw, *hg_norm_w,
                *ln_mix_g, *ln_mix_b, *w_up, *w_down, *ln_ffn_g, *ln_ffn_b;
    float* out; unsigned char* ws;
};

__device__ __forceinline__ unsigned pk2(float lo, float hi) { unsigned r; asm("v_cvt_pk_bf16_f32 %0, %1, %2" : "=v"(r) : "v"(lo), "v"(hi)); return r; }
__device__ __forceinline__ float bflo(unsigned u) { return __uint_as_float(u << 16); }
__device__ __forceinline__ float bfhi(unsigned u) { return __uint_as_float(u & 0xffff0000u); }
__device__ __forceinline__ float bf2f(bf16_t h) { return __uint_as_float((unsigned)h << 16); }
__device__ __forceinline__ bf16_t f2bf(float f) { return (bf16_t)(pk2(f, 0.f) & 0xffffu); }
__device__ __forceinline__ void unpack8(u32x4 u, float* f) { f[0] = bflo(u.x); f[1] = bfhi(u.x); f[2] = bflo(u.y); f[3] = bfhi(u.y); f[4] = bflo(u.z); f[5] = bfhi(u.z); f[6] = bflo(u.w); f[7] = bfhi(u.w); }
__device__ __forceinline__ u32x4 pack8(const float* f) { u32x4 u; u.x = pk2(f[0], f[1]); u.y = pk2(f[2], f[3]); u.z = pk2(f[4], f[5]); u.w = pk2(f[6], f[7]); return u; }
__device__ __forceinline__ bf16x8 as_bf8(u32x4 u) { return __builtin_bit_cast(bf16x8, u); }
__device__ __forceinline__ f32x4 mfma16(bf16x8 a, bf16x8 b, f32x4 c) { return __builtin_amdgcn_mfma_f32_16x16x32_bf16(a, b, c, 0, 0, 0); }
__device__ __forceinline__ void sincos_red(float a, float& s, float& c) {
    float k = rintf(a * 0.15915494309189535f);
    float r = fmaf(-k, 6.2831854820251465f, a);
    r = fmaf(k, 1.7484555e-7f, r);
    s = __sinf(r); c = __cosf(r);
}
__device__ __forceinline__ float ret_inv(int i) { return exp2f(-(float)i * 0.88584749f); }
__device__ __forceinline__ float swa_inv(int i) { return exp2f(-(float)i * 2.36644607f); }
__device__ __forceinline__ float ret_lg(int h) { return logf(1.0f - exp2f(-5.0f - (float)h)); }
__device__ __forceinline__ float lb_val(const float* raw, int l, int col) {
    float r0 = raw[col], r1 = raw[256 + col], r2 = raw[512 + col], r3 = raw[768 + col];
    float m = fmaxf(fmaxf(r0, r1), fmaxf(r2, r3));
    float e0 = expf(r0 - m), e1 = expf(r1 - m), e2 = expf(r2 - m), e3 = expf(r3 - m);
    float s = e0 + e1 + e2 + e3, a = 0.f;
    if (l >= 1) a += e1; if (l >= 2) a += e2; if (l >= 3) a += e3;
    return a / s;
}
__device__ __forceinline__ int otid() { int t = threadIdx.x; asm volatile("" : "+v"(t)); return t; }
__device__ __forceinline__ float silu(float g) { return g / (1.0f + expf(-g)); }

__device__ void transpose_convert(unsigned char* lds, const float* __restrict__ W, bf16_t* __restrict__ Wt, int K, int N) {
    float* tile = (float*)lds;
    const int tid = otid(), tn = N / 64, nt = (K / 64) * tn;
    for (int u = blockIdx.x; u < nt; u += gridDim.x) {
        const int k0 = (u / tn) * 64, n0 = (u % tn) * 64;
        __syncthreads();
#pragma unroll
        for (int i = 0; i < 2; ++i) { const int idx = tid + i * 512, r = idx >> 4, c4 = (idx & 15) * 4;
            const float4 v = *(const float4*)(W + (size_t)(k0 + r) * N + n0 + c4);
            tile[r * 65 + c4] = v.x; tile[r * 65 + c4 + 1] = v.y; tile[r * 65 + c4 + 2] = v.z; tile[r * 65 + c4 + 3] = v.w; }
        __syncthreads();
        const int n = tid >> 3, kk = (tid & 7) * 8; float f[8];
#pragma unroll
        for (int j = 0; j < 8; ++j) f[j] = tile[(kk + j) * 65 + n];
        *(u32x4*)(Wt + (size_t)(n0 + n) * K + k0 + kk) = pack8(f);
    }
}
__device__ void prep_phase(unsigned char* lds, const Params& p) {
    for (int l = 0; l < 4; ++l) {
        transpose_convert(lds, p.w_in + (size_t)l * DM * NIN, (bf16_t*)(p.ws + WS_WIN) + (size_t)l * NIN * DM, DM, NIN);
        transpose_convert(lds, p.w_out + (size_t)l * DM * DM, (bf16_t*)(p.ws + WS_WOUT) + (size_t)l * DM * DM, DM, DM);
        transpose_convert(lds, p.w_up + (size_t)l * DM * DFF, (bf16_t*)(p.ws + WS_WUP) + (size_t)l * DFF * DM, DM, DFF);
        transpose_convert(lds, p.w_down + (size_t)l * DFF * DM, (bf16_t*)(p.ws + WS_WDN) + (size_t)l * DM * DFF, DFF, DM);
    }
    float* X = p.out; bf16_t* Xb = (bf16_t*)(p.ws + WS_XB);
    const size_t n4 = (size_t)TT * DM / 4, np4 = (size_t)TP * DM / 4;
    for (size_t i = (size_t)blockIdx.x * NT + threadIdx.x; i < n4; i += (size_t)gridDim.x * NT) {
        const float4 v = (i < np4) ? ((const float4*)p.x_prompt)[i] : ((const float4*)p.x_sample)[i - np4];
        ((float4*)X)[i] = v; u32x2 w; w.x = pk2(v.x, v.y); w.y = pk2(v.z, v.w); ((u32x2*)Xb)[i] = w;
    }
}

struct EpiH { bf16_t* H; __device__ __forceinline__ void operator()(int row, int col, f32x4 v) const { u32x2 w; w.x = pk2(v[0], v[1]); w.y = pk2(v[2], v[3]); *(u32x2*)(H + (size_t)row * NIN + col) = w; } };
struct EpiRes { float* X; __device__ __forceinline__ void operator()(int row, int col, f32x4 v) const { f32x4* q = (f32x4*)(X + (size_t)row * DM + col); *q = *q * ALPHA + v; } };
struct EpiRelu2 { bf16_t* HF; __device__ __forceinline__ void operator()(int row, int col, f32x4 v) const { u32x2 w; float a = fmaxf(v[0], 0.f), b = fmaxf(v[1], 0.f), c = fmaxf(v[2], 0.f), d = fmaxf(v[3], 0.f); w.x = pk2(a * a, b * b); w.y = pk2(c * c, d * d); *(u32x2*)(HF + (size_t)row * DFF + col) = w; } };

template <class Epi>
__device__ void gemm_phase(unsigned char* lds, const bf16_t* __restrict__ A, const bf16_t* __restrict__ Bt, int M, int N, int K, const Epi& epi) {
    constexpr int BM = 256, BN = 128, BK = 64, LS = 72;
    bf16_t* sA = (bf16_t*)lds; bf16_t* sB = sA + BM * LS;
    const int tid = otid(), lane = tid & 63, wid = tid >> 6, fr = lane & 15, g = lane >> 4, wr = wid >> 1, wc = wid & 1;
    const int nN = N / BN, units = (M / BM) * nN;
    for (int u = blockIdx.x; u < units; u += gridDim.x) {
        const int pm = u / nN, pn = u % nN;
        const bf16_t* Ab = A + (size_t)pm * BM * K; const bf16_t* Bb = Bt + (size_t)pn * BN * K;
        f32x4 acc[4][4];
#pragma unroll
        for (int a = 0; a < 4; ++a)
#pragma unroll
            for (int b = 0; b < 4; ++b) acc[a][b] = (f32x4){0.f, 0.f, 0.f, 0.f};
        u32x4 ra[4], rb[2];
#pragma unroll
        for (int i = 0; i < 4; ++i) { const int idx = tid + i * 512; ra[i] = *(const u32x4*)(Ab + (size_t)(idx >> 3) * K + (idx & 7) * 8); }
#pragma unroll
        for (int i = 0; i < 2; ++i) { const int idx = tid + i * 512; rb[i] = *(const u32x4*)(Bb + (size_t)(idx >> 3) * K + (idx & 7) * 8); }
        for (int k0 = 0; k0 < K; k0 += BK) {
            __syncthreads();
#pragma unroll
            for (int i = 0; i < 4; ++i) { const int idx = tid + i * 512; *(u32x4*)(sA + (idx >> 3) * LS + (idx & 7) * 8) = ra[i]; }
#pragma unroll
            for (int i = 0; i < 2; ++i) { const int idx = tid + i * 512; *(u32x4*)(sB + (idx >> 3) * LS + (idx & 7) * 8) = rb[i]; }
            __syncthreads();
            if (k0 + BK < K) {
#pragma unroll
                for (int i = 0; i < 4; ++i) { const int idx = tid + i * 512; ra[i] = *(const u32x4*)(Ab + (size_t)(idx >> 3) * K + k0 + BK + (idx & 7) * 8); }
#pragma unroll
                for (int i = 0; i < 2; ++i) { const int idx = tid + i * 512; rb[i] = *(const u32x4*)(Bb + (size_t)(idx >> 3) * K + k0 + BK + (idx & 7) * 8); }
            }
#pragma unroll
            for (int ks = 0; ks < 2; ++ks) {
                bf16x8 af[4], bfr[4];
#pragma unroll
                for (int m = 0; m < 4; ++m) af[m] = *(const bf16x8*)(sA + (wr * 64 + m * 16 + fr) * LS + ks * 32 + g * 8);
#pragma unroll
                for (int n = 0; n < 4; ++n) bfr[n] = *(const bf16x8*)(sB + (wc * 64 + n * 16 + fr) * LS + ks * 32 + g * 8);
#pragma unroll
                for (int m = 0; m < 4; ++m)
#pragma unroll
                    for (int n = 0; n < 4; ++n) acc[m][n] = mfma16(bfr[n], af[m], acc[m][n]);
            }
        }
#pragma unroll
        for (int m = 0; m < 4; ++m)
#pragma unroll
            for (int n = 0; n < 4; ++n) epi(pm * BM + wr * 64 + m * 16 + fr, pn * BN + wc * 64 + n * 16 + g * 4, acc[m][n]);
    }
}

namespace pg8 {
#define PG8_LAS __attribute__((address_space(3)))
typedef unsigned short bf16_t;
typedef short bf16x8 __attribute__((ext_vector_type(8)));
typedef float f32x4 __attribute__((ext_vector_type(4)));
typedef unsigned u32x4 __attribute__((ext_vector_type(4)));
constexpr int BM = 256, BK = 64, HALF = 128, HTB = HALF * BK * 2  , STAGE_BYTES = 8 * HTB, NXCD = 8, WGM = 8;

__host__ __device__ __forceinline__ int lds_byte(int r, int c) { const int st = (r >> 4) * 2 + (c >> 5), rr = r & 15, cc = c & 31, ob = rr * 64 + cc * 2; return st * 1024 + (ob ^ (((ob >> 9) & 1) << 5)); }
__host__ __device__ __forceinline__ void stage_rc(int b, int& R, int& C) { const int st = b / 1024, sb = b % 1024, swz = sb ^ (((sb >> 9) & 1) << 5); R = (st >> 1) * 16 + swz / 64; C = (st & 1) * 32 + (swz % 64) / 2; }
__host__ __device__ __forceinline__ int perm32(int rho) { const int n = rho >> 4, i = rho & 15; return 8 * (i >> 2) + 4 * n + (i & 3); }

struct Unit { int pm, pn; };
struct Gemm { const bf16_t* A; const bf16_t* Bt; int M, N, K; };

struct StaticOrder {
    int nM, nN, nwg, G, c;
    __host__ __device__ void init(int M, int N, int G_, int c_) { nM = M / BM; nN = N / BM; nwg = nM * nN; G = G_; c = c_; }
    __host__ __device__ bool next(int i, Unit& u) const {
        const long L = (long)i * G + c; if (L >= nwg) return false;
        int wgid = (int)L; { const int q = nwg / NXCD, r = nwg % NXCD, xcd = wgid % NXCD, off = wgid / NXCD; wgid = (xcd < r ? xcd * (q + 1) : r * (q + 1) + (xcd - r) * q) + off; }
        const int nig = WGM * nN, gid = wgid / nig, fm = gid * WGM, gsz = (nM - fm) < WGM ? (nM - fm) : WGM;
        u.pm = fm + ((wgid % nig) % gsz); u.pn = (wgid % nig) / gsz; return true;
    }
    __device__ __forceinline__ void a_ready(const Unit&) const {}
    __device__ __forceinline__ void done(const Unit&) const {}
};

__device__ __forceinline__ unsigned cvt_pk_bf16(float lo, float hi) { unsigned r; asm volatile("v_cvt_pk_bf16_f32 %0, %1, %2" : "=v"(r) : "v"(lo), "v"(hi)); return r; }
template <int ACT  > struct EpiB16 {
    static constexpr bool PERM = true, AFTER_DRAIN = false;
    bf16_t* O; int ldc;
    __device__ __forceinline__ void operator()(const f32x4 (&acc)[2][2][4][2], const Unit& u, int wr, int wc, int fr, int fq) const {
        const int row0 = u.pm * BM + wr * 64 + fr, col0 = u.pn * BM + wc * 32 + 8 * fq;
#pragma unroll
        for (int ai = 0; ai < 2; ++ai)
#pragma unroll
            for (int m = 0; m < 4; ++m) { bf16_t* rowp = O + (size_t)(row0 + ai * HALF + m * 16) * ldc + col0;
#pragma unroll
                for (int bj = 0; bj < 2; ++bj) { f32x4 v0 = acc[ai][bj][m][0], v1 = acc[ai][bj][m][1];
                    if (ACT == 1) {
#pragma unroll
                        for (int j = 0; j < 4; ++j) { const float a = fmaxf(v0[j], 0.f), b = fmaxf(v1[j], 0.f); v0[j] = a * a; v1[j] = b * b; } }
                    u32x4 w; w.x = cvt_pk_bf16(v0[0], v0[1]); w.y = cvt_pk_bf16(v0[2], v0[3]); w.z = cvt_pk_bf16(v1[0], v1[1]); w.w = cvt_pk_bf16(v1[2], v1[3]);
                    *(u32x4*)(rowp + bj * HALF) = w; } }
    }
};
struct EpiResF32 {
    static constexpr bool PERM = false, AFTER_DRAIN = false;
    float* X; int ldc; float alpha;
    __device__ __forceinline__ void operator()(const f32x4 (&acc)[2][2][4][2], const Unit& u, int wr, int wc, int fr, int fq) const {
        const int row0 = u.pm * BM + wr * 64 + fr, col0 = u.pn * BM + wc * 32 + 4 * fq;
#pragma unroll
        for (int ai = 0; ai < 2; ++ai)
#pragma unroll
            for (int m = 0; m < 4; ++m) { float* rowp = X + (size_t)(row0 + ai * HALF + m * 16) * ldc + col0;
#pragma unroll
                for (int bj = 0; bj < 2; ++bj)
#pragma unroll
                    for (int n = 0; n < 2; ++n) { f32x4* q = (f32x4*)(rowp + bj * HALF + n * 16); *q = *q * alpha + acc[ai][bj][m][n]; } }
    }
};
template <class Epi, class Sched, bool STAMP = false>
__device__ __forceinline__ void gemm_phase(PG8_LAS unsigned char* lds, const Gemm g, const Sched& S, const Epi& E, unsigned long long* stamps) {
    int tid = threadIdx.x; asm volatile("" : "+v"(tid)); const int wid = __builtin_amdgcn_readfirstlane(tid >> 6), lane = tid & 63, wr = wid >> 2, wc = wid & 3, fr = lane & 15, fq = lane >> 4;
    const int K = g.K, nt = K / BK;
    int ts_lo = 0, ts_hi = 0, nts = 0; const unsigned long long rt_entry = STAMP ? (unsigned long long)wall_clock64() : 0ull;
#define PG8_STAMP() do { if (STAMP && wid == 0 && nts < 64) { const unsigned long long _c = (unsigned long long)clock64(); \
        ts_lo = (lane == nts) ? (int)(unsigned)_c : ts_lo; ts_hi = (lane == nts) ? (int)(unsigned)(_c >> 32) : ts_hi; ++nts; } } while (0)
    PG8_STAMP();
    unsigned voffA[2], voffB[2];
#pragma unroll
    for (int i = 0; i < 2; ++i) { int R, C; stage_rc(tid * 16 + i * 8192, R, C); const int Rb = Epi::PERM ? ((R & ~31) + perm32(R & 31)) : R;
        voffA[i] = (unsigned)(R * K + C) * 2u; voffB[i] = (unsigned)(Rb * K + C) * 2u; }
    const size_t kstep = (size_t)(BK * 2);
    const size_t hstep = (size_t)HALF * K * 2;
    const size_t tstep = 2 * hstep;
    const unsigned ldsw = (unsigned)wid * 1024u;
    const int aoff = lds_byte(wr * 64 + fr, fq * 8), boff = lds_byte(wc * 32 + fr, fq * 8);
#define PG8_SA(b, h) (((b) * 2 + (h)) * HTB)
#define PG8_SB(b, h) ((4 + (b) * 2 + (h)) * HTB)
#define PG8_STAGE(bufoff, gbase, voff) do { _Pragma("unroll") for (int _i = 0; _i < 2; ++_i) \
        __builtin_amdgcn_global_load_lds((const unsigned*)((const char*)(gbase) + (voff)[_i]), (PG8_LAS unsigned*)(lds + (bufoff) + ldsw + _i * 8192), 16, 0, 0); } while (0)
#define PG8_LDA(dst, b, h) do { _Pragma("unroll") for (int m = 0; m < 4; ++m) _Pragma("unroll") for (int k = 0; k < 2; ++k) dst[m][k] = *(const PG8_LAS bf16x8*)(lds + PG8_SA(b, h) + aoff + m * 2048 + k * 1024); } while (0)
#define PG8_LDB(dst, b, h) do { _Pragma("unroll") for (int n = 0; n < 2; ++n) _Pragma("unroll") for (int k = 0; k < 2; ++k) dst[n][k] = *(const PG8_LAS bf16x8*)(lds + PG8_SB(b, h) + boff + n * 2048 + k * 1024); } while (0)
#define PG8_MMA(ai, bj, At, Bt) do { __builtin_amdgcn_s_setprio(1); _Pragma("unroll") for (int m = 0; m < 4; ++m) _Pragma("unroll") for (int n = 0; n < 2; ++n) _Pragma("unroll") for (int k = 0; k < 2; ++k) \
        acc[ai][bj][m][n] = __builtin_amdgcn_mfma_f32_16x16x32_bf16(Bt[n][k], At[m][k], acc[ai][bj][m][n], 0, 0, 0); __builtin_amdgcn_s_setprio(0); } while (0)
#define PG8_WAIT_V(n) asm volatile("s_waitcnt vmcnt(" #n ")" ::: "memory")
#define PG8_WAIT_L(n) asm volatile("s_waitcnt lgkmcnt(" #n ")" ::: "memory")
#define PG8_BAR __builtin_amdgcn_s_barrier()
#define PG8_SCHED __builtin_amdgcn_sched_barrier(0)
    Unit cur, nxt; int ui = 0;
    if (!S.next(0, cur)) return;
    f32x4 acc[2][2][4][2];
#pragma unroll
    for (int a = 0; a < 2; ++a)
#pragma unroll
        for (int b = 0; b < 2; ++b)
#pragma unroll
            for (int m = 0; m < 4; ++m)
#pragma unroll
                for (int n = 0; n < 2; ++n) acc[a][b][m][n] = (f32x4){0.f, 0.f, 0.f, 0.f};
    bf16x8 At[4][2], B0[2][2], B1[2][2];
    const char* cA = (const char*)g.A + (size_t)cur.pm * tstep; const char* cB = (const char*)g.Bt + (size_t)cur.pn * tstep;
    S.a_ready(cur);
    PG8_STAGE(PG8_SB(0, 0), cB, voffB); PG8_STAGE(PG8_SA(0, 0), cA, voffA); PG8_STAGE(PG8_SB(0, 1), cB + hstep, voffB); PG8_STAGE(PG8_SA(0, 1), cA + hstep, voffA);
    if (wr == 1) PG8_BAR;
    PG8_WAIT_V(4); PG8_BAR;
    PG8_STAGE(PG8_SB(1, 0), cB + kstep, voffB); PG8_STAGE(PG8_SA(1, 0), cA + kstep, voffA); PG8_STAGE(PG8_SB(1, 1), cB + hstep + kstep, voffB);
    PG8_WAIT_V(6); PG8_BAR;
    PG8_STAMP();
    for (;;) {
        const bool has_next = S.next(ui + 1, nxt);
        const char* nA = has_next ? (const char*)g.A + (size_t)nxt.pm * tstep : cA; const char* nB = has_next ? (const char*)g.Bt + (size_t)nxt.pn * tstep : cB;
        for (int t = 0; t < nt; t += 2) {
            const bool last = (t == nt - 2);
            const char* a1 = cA + (size_t)(t + 1) * kstep;
            const char* a2 = last ? nA : cA + (size_t)(t + 2) * kstep; const char* b2 = last ? nB : cB + (size_t)(t + 2) * kstep;
            const char* a3 = a2 + kstep; const char* b3 = b2 + kstep;
            if (last && has_next) S.a_ready(nxt);
            PG8_LDB(B0, 0, 0); PG8_SCHED; PG8_LDA(At, 0, 0); PG8_STAGE(PG8_SA(1, 1), a1 + hstep, voffA);
            PG8_WAIT_L(8); PG8_BAR; PG8_WAIT_L(0); PG8_MMA(0, 0, At, B0); PG8_BAR; PG8_SCHED;
            PG8_LDB(B1, 0, 1); PG8_STAGE(PG8_SB(0, 0), b2, voffB);
            PG8_BAR; PG8_WAIT_L(0); PG8_MMA(0, 1, At, B1); PG8_BAR;
            PG8_LDA(At, 0, 1); PG8_STAGE(PG8_SA(0, 0), a2, voffA);
            PG8_BAR; PG8_WAIT_L(0); PG8_MMA(1, 0, At, B0); PG8_BAR; PG8_SCHED;
            PG8_STAGE(PG8_SB(0, 1), b2 + hstep, voffB);
            PG8_WAIT_V(6); PG8_BAR; PG8_MMA(1, 1, At, B1); PG8_BAR;
            PG8_LDB(B0, 1, 0); PG8_SCHED; PG8_LDA(At, 1, 0); PG8_STAGE(PG8_SA(0, 1), a2 + hstep, voffA);
            PG8_WAIT_L(8); PG8_BAR; PG8_WAIT_L(0); PG8_MMA(0, 0, At, B0); PG8_BAR; PG8_SCHED;
            PG8_LDB(B1, 1, 1); PG8_STAGE(PG8_SB(1, 0), b3, voffB);
            PG8_BAR; PG8_WAIT_L(0); PG8_MMA(0, 1, At, B1); PG8_BAR;
            PG8_LDA(At, 1, 1); PG8_STAGE(PG8_SA(1, 0), a3, voffA);
            PG8_BAR; PG8_WAIT_L(0); PG8_MMA(1, 0, At, B0); PG8_BAR; PG8_SCHED;
            PG8_STAGE(PG8_SB(1, 1), b3 + hstep, voffB);
            PG8_WAIT_V(6); PG8_BAR; PG8_MMA(1, 1, At, B1); PG8_BAR;
        }
        PG8_STAMP();
        if constexpr (!Epi::AFTER_DRAIN) { E(acc, cur, wr, wc, fr, fq); S.done(cur); }
        PG8_STAMP();
        if (!has_next) break;
#pragma unroll
        for (int a = 0; a < 2; ++a)
#pragma unroll
            for (int b = 0; b < 2; ++b)
#pragma unroll
                for (int m = 0; m < 4; ++m)
#pragma unroll
                    for (int n = 0; n < 2; ++n) acc[a][b][m][n] = (f32x4){0.f, 0.f, 0.f, 0.f};
        cur = nxt; cA = nA; cB = nB; ++ui;
    }
    PG8_WAIT_V(0);
    if (wr == 0) PG8_BAR;
    PG8_BAR;
    if constexpr (Epi::AFTER_DRAIN) { E.fused(acc, cur, wr, wc, fr, fq, lds, wid, lane); S.done(cur); }
    PG8_STAMP();
    if (STAMP && wid == 0) { stamps[lane] = lane < nts ? (((unsigned long long)(unsigned)ts_hi << 32) | (unsigned)ts_lo) : 0ull;
        if (lane == 62) stamps[62] = rt_entry; if (lane == 63) stamps[63] = (unsigned long long)wall_clock64(); }
#undef PG8_STAMP
#undef PG8_SA
#undef PG8_SB
#undef PG8_STAGE
#undef PG8_LDA
#undef PG8_LDB
#undef PG8_MMA
#undef PG8_WAIT_V
#undef PG8_WAIT_L
#undef PG8_BAR
#undef PG8_SCHED
}
}


template <int N, int K, class Epi>
__device__ void small_gemm(unsigned char* lds, const bf16_t* __restrict__ A, const bf16_t* __restrict__ Bt, const Epi& epi) {
    constexpr int BN = N / 32, NTL = BN / 16, KS = (NTL == 2) ? 4 : 1, KW = K / KS, UN = 4;
    const int tid = otid(), lane = tid & 63, wid = tid >> 6, fr = lane & 15, g = lane >> 4;
    float* red = (float*)lds;
    for (int u = blockIdx.x; u < 256; u += gridDim.x) {
        const int mt = u & 7, ntile = u >> 3, nt = wid % NTL, ks = wid / NTL; const bool active = wid < NTL * KS;
        f32x4 acc[4];
#pragma unroll
        for (int m = 0; m < 4; ++m) acc[m] = (f32x4){0.f, 0.f, 0.f, 0.f};
        if (active) {
            const bf16_t* Ap = A + (size_t)(mt * 64 + fr) * K + ks * KW + g * 8;
            const bf16_t* Bp = Bt + (size_t)(ntile * BN + nt * 16 + fr) * K + ks * KW + g * 8;
#pragma unroll 1
            for (int k = 0; k < KW; k += 32 * UN) {
                bf16x8 a[UN][4], b[UN];
#pragma unroll
                for (int i = 0; i < UN; ++i) { b[i] = *(const bf16x8*)(Bp + k + i * 32);
#pragma unroll
                    for (int m = 0; m < 4; ++m) a[i][m] = *(const bf16x8*)(Ap + (size_t)m * 16 * K + k + i * 32); }
#pragma unroll
                for (int i = 0; i < UN; ++i)
#pragma unroll
                    for (int m = 0; m < 4; ++m) acc[m] = mfma16(b[i], a[i][m], acc[m]);
            }
        }
        if (KS > 1) {
            __syncthreads();
#pragma unroll
            for (int m = 0; m < 4; ++m) *(f32x4*)(red + ((ks * 64 + m * 16 + fr) * BN + nt * 16 + g * 4)) = acc[m];
            __syncthreads();
            const int row = tid >> 3, c4 = (tid & 7) * 4;
            f32x4 s = *(const f32x4*)(red + (row * BN + c4));
#pragma unroll
            for (int q = 1; q < KS; ++q) s += *(const f32x4*)(red + ((q * 64 + row) * BN + c4));
            epi(TP + mt * 64 + row, ntile * BN + c4, s);
        } else if (active) {
#pragma unroll
            for (int m = 0; m < 4; ++m) epi(TP + mt * 64 + m * 16 + fr, ntile * BN + nt * 16 + g * 4, acc[m]);
        }
    }
}
__device__ void ln_phase(float* X, bf16_t* Xb, const float* __restrict__ gam, const float* __restrict__ bet) {
    const int tid = otid(), lane = tid & 63, wid = tid >> 6;
    for (int row = blockIdx.x * 8 + wid; row < TT; row += gridDim.x * 8) {
        f32x4 v[4]; float s = 0.f;
#pragma unroll
        for (int i = 0; i < 4; ++i) { v[i] = *(const f32x4*)(X + (size_t)row * DM + i * 256 + lane * 4); s += (v[i][0] + v[i][1]) + (v[i][2] + v[i][3]); }
#pragma unroll
        for (int o = 1; o < 64; o <<= 1) s += __shfl_xor(s, o);
        const float mu = s * (1.0f / 1024.0f); float q = 0.f;
#pragma unroll
        for (int i = 0; i < 4; ++i) { const f32x4 d = v[i] - mu; q += (d[0] * d[0] + d[1] * d[1]) + (d[2] * d[2] + d[3] * d[3]); }
#pragma unroll
        for (int o = 1; o < 64; o <<= 1) q += __shfl_xor(q, o);
        const float rstd = rsqrtf(q * (1.0f / 1024.0f) + 1e-5f);
#pragma unroll
        for (int i = 0; i < 4; ++i) { const int c = i * 256 + lane * 4; const f32x4 gg = *(const f32x4*)(gam + c), bb = *(const f32x4*)(bet + c);
            const f32x4 o = (v[i] - mu) * rstd * gg + bb; *(f32x4*)(X + (size_t)row * DM + c) = o;
            u32x2 w; w.x = pk2(o[0], o[1]); w.y = pk2(o[2], o[3]); *(u32x2*)(Xb + (size_t)row * DM + c) = w; }
    }
}

constexpr int QS = 72, BS = 68, VS = 136;
template <int DK, bool WITH_Q>
__device__ void stage_chunk(unsigned char* lds, const Params& p, int l, int n, int h, int c) {
    constexpr bool HG = (DK == 64);
    bf16_t* sQ = (bf16_t*)lds; bf16_t* sK = (bf16_t*)(lds + 18432); float* sB = (float*)(lds + 36864); bf16_t* sVt = (bf16_t*)(lds + 71680); float* sTot = (float*)(lds + 106496);
    const bf16_t* H = (const bf16_t*)(p.ws + WS_R1);
    const int tid = otid(); const int row0 = n * SEQ + c * 128;
    if (HG) {
#pragma unroll
        for (int i = 0; i < 2; ++i) { const int idx = tid + i * 512, t = idx >> 3, dg = idx & 7; const bf16_t* hr = H + (size_t)(row0 + t) * NIN;
            float hf[8], kk[8]; unpack8(*(const u32x4*)(hr + C_HF + h * 64 + dg * 8), hf);
#pragma unroll
            for (int j = 0; j < 8; ++j) { const float lb = lb_val(p.lb_raw, l, h * 64 + dg * 8 + j); const float k = (1.0f - lb) / (1.0f + expf(hf[j])); kk[j] = k; sB[t * BS + dg * 8 + j] = log1pf(-k); }
            *(u32x4*)(sK + t * QS + dg * 8) = pack8(kk);
            if (WITH_Q) *(u32x4*)(sQ + t * QS + dg * 8) = *(const u32x4*)(hr + C_HQ + h * 64 + dg * 8);
            float vv[8]; unpack8(*(const u32x4*)(hr + C_HI + h * 64 + dg * 8), vv);
#pragma unroll
            for (int j = 0; j < 8; ++j) sVt[(dg * 8 + j) * VS + t] = f2bf(vv[j]);
        }
        __syncthreads();
        { const int d = tid & 63, seg = tid >> 6; float a = 0.f;
#pragma unroll
          for (int j = 0; j < 16; ++j) { a += sB[(seg * 16 + j) * BS + d]; sB[(seg * 16 + j) * BS + d] = a; }
          sTot[seg * 64 + d] = a;
          __syncthreads();
          float off = 0.f;
          for (int s2 = 0; s2 < seg; ++s2) off += sTot[s2 * 64 + d];
          if (seg > 0) {
#pragma unroll
              for (int j = 0; j < 16; ++j) sB[(seg * 16 + j) * BS + d] += off; }
        }
    } else {
        const float lg = ret_lg(h);
        if (tid < 256) { const int t = tid >> 1, ig = tid & 1; const bf16_t* hr = H + (size_t)(row0 + t) * NIN; const float pos = (float)(c * 128 + t);
            float k1[8], k2[8], o1[8], o2[8], cs[8], sn[8];
#pragma unroll
            for (int j = 0; j < 8; ++j) sincos_red(pos * ret_inv(ig * 8 + j), sn[j], cs[j]);
            unpack8(*(const u32x4*)(hr + C_RK + h * 32 + ig * 8), k1); unpack8(*(const u32x4*)(hr + C_RK + h * 32 + 16 + ig * 8), k2);
#pragma unroll
            for (int j = 0; j < 8; ++j) { o1[j] = (k1[j] * cs[j] - k2[j] * sn[j]) * 0.17677669529663687f; o2[j] = (k2[j] * cs[j] + k1[j] * sn[j]) * 0.17677669529663687f; }
            *(u32x4*)(sK + t * QS + ig * 8) = pack8(o1); *(u32x4*)(sK + t * QS + 16 + ig * 8) = pack8(o2);
            if (WITH_Q) {
                unpack8(*(const u32x4*)(hr + C_RQ + h * 32 + ig * 8), k1); unpack8(*(const u32x4*)(hr + C_RQ + h * 32 + 16 + ig * 8), k2);
#pragma unroll
                for (int j = 0; j < 8; ++j) { o1[j] = k1[j] * cs[j] - k2[j] * sn[j]; o2[j] = k2[j] * cs[j] + k1[j] * sn[j]; }
                *(u32x4*)(sQ + t * QS + ig * 8) = pack8(o1); *(u32x4*)(sQ + t * QS + 16 + ig * 8) = pack8(o2);
            }
        }
#pragma unroll
        for (int i = 0; i < 8; ++i) { const int idx = tid + i * 512, t = idx >> 5, d = idx & 31; sB[t * BS + d] = (float)(t + 1) * lg; }
#pragma unroll
        for (int i = 0; i < 2; ++i) { const int idx = tid + i * 512, t = idx >> 3, dg = idx & 7; const bf16_t* hr = H + (size_t)(row0 + t) * NIN;
            float vv[8]; unpack8(*(const u32x4*)(hr + C_RV + h * 64 + dg * 8), vv);
#pragma unroll
            for (int j = 0; j < 8; ++j) sVt[(dg * 8 + j) * VS + t] = f2bf(vv[j]);
        }
    }
    __syncthreads();
}

template <int DK>
__device__ void local_state_item(unsigned char* lds, const Params& p, int l, int n, int h, int c) {
    constexpr bool HG = (DK == 64);
    bf16_t* sK = (bf16_t*)(lds + 18432); float* sB = (float*)(lds + 36864); bf16_t* sVt = (bf16_t*)(lds + 71680); bf16_t* sKt = (bf16_t*)(lds + 89088);
    const int tid = otid(), lane = tid & 63, wid = tid >> 6, fr = lane & 15, g = lane >> 4;
    __syncthreads();
    stage_chunk<DK, false>(lds, p, l, n, h, c);
    for (int idx = tid; idx < 128 * DK / 8; idx += 512) { const int t = idx / (DK / 8), dg = idx % (DK / 8);
        float kk[8]; unpack8(*(const u32x4*)(sK + t * QS + dg * 8), kk);
#pragma unroll
        for (int j = 0; j < 8; ++j) { const int d = dg * 8 + j; sKt[d * VS + t] = f2bf(kk[j] * expf(sB[127 * BS + d] - sB[t * BS + d])); }
    }
    const int ci = (n * 4 + h) * 64 + c;
    if (HG && tid < 64) ((float*)(p.ws + WS_DEC))[ci * 64 + tid] = expf(sB[127 * BS + tid]);
    __syncthreads();
    float* Sl = (float*)(p.ws + (HG ? WS_SLH : WS_SLR)) + (size_t)ci * DK * 64;
    constexpr int NTILE = HG ? 2 : 1;
#pragma unroll
    for (int tt = 0; tt < NTILE; ++tt) {
        const int dt = HG ? (wid >> 1) : (wid >> 2), vt = HG ? ((wid & 1) * 2 + tt) : (wid & 3);
        f32x4 acc = (f32x4){0.f, 0.f, 0.f, 0.f};
#pragma unroll
        for (int ks = 0; ks < 4; ++ks) {
            const bf16x8 a = *(const bf16x8*)(sKt + (dt * 16 + fr) * VS + ks * 32 + g * 8);
            const bf16x8 b = *(const bf16x8*)(sVt + (vt * 16 + fr) * VS + ks * 32 + g * 8);
            acc = mfma16(a, b, acc);
        }
#pragma unroll
        for (int j = 0; j < 4; ++j) Sl[(dt * 16 + g * 4 + j) * 64 + vt * 16 + fr] = acc[j];
    }
}

__device__ void scan_phase(const Params& p, int l) {
    const int gt = blockIdx.x * NT + otid();
    if (gt < 32768 + 16384) {
        const bool hg = gt < 32768; const int g2 = hg ? gt : gt - 32768;
        const int esz = hg ? 4096 : 2048, ch = hg ? (g2 >> 12) : (g2 >> 11), e = g2 & (esz - 1);
        const float* Sl = (const float*)(p.ws + (hg ? WS_SLH : WS_SLR)) + (size_t)ch * 64 * esz + e;
        float* Si = (float*)(p.ws + (hg ? WS_SIH : WS_SIR)) + (size_t)ch * 64 * esz + e;
        const float* dec = (const float*)(p.ws + WS_DEC) + (size_t)ch * 64 * 64 + (e >> 6);
        const float dc = expf(128.0f * ret_lg(ch & 3));
        float S = 0.f;
#pragma unroll 1
        for (int c0 = 0; c0 < 64; c0 += 8) { float sl[8], dd[8];
#pragma unroll
            for (int j = 0; j < 8; ++j) { sl[j] = Sl[(size_t)j * esz]; dd[j] = hg ? dec[j * 64] : dc; }
#pragma unroll
            for (int j = 0; j < 8; ++j) { Si[(size_t)j * esz] = S; S = dd[j] * S + sl[j]; }
            Sl += (size_t)8 * esz; Si += (size_t)8 * esz; dec += 8 * 64; }
        p.out[(hg ? O_PH : O_PR) + (size_t)(l * 8 + ch) * esz + e] = S;
    }
}

template <int DK>
__device__ void chunk_out_item(unsigned char* lds, const Params& p, int l, int n, int h, int c) {
    constexpr bool HG = (DK == 64); constexpr int NKS = DK / 32;
    bf16_t* sQ = (bf16_t*)lds; bf16_t* sK = (bf16_t*)(lds + 18432); float* sB = (float*)(lds + 36864); bf16_t* sVt = (bf16_t*)(lds + 71680); bf16_t* sS0 = (bf16_t*)(lds + 89088);
    const bf16_t* H = (const bf16_t*)(p.ws + WS_R1); bf16_t* CAT = (bf16_t*)(p.ws + WS_CAT);
    const int tid = otid(), lane = tid & 63, wid = tid >> 6, fr = lane & 15, g = lane >> 4;
    __syncthreads();
    const int ci = (n * 4 + h) * 64 + c;
    { const float* Si = (const float*)(p.ws + (HG ? WS_SIH : WS_SIR)) + (size_t)ci * DK * 64;
      for (int idx = tid; idx < DK * 64; idx += 512) { const int d = idx >> 6, v = idx & 63; sS0[v * QS + d] = f2bf(Si[idx]); } }
    stage_chunk<DK, true>(lds, p, l, n, h, c);
    const int i = wid, t = 16 * i + fr;
    bf16x8 qt[NKS], qh[NKS]; float r[NKS][8];
#pragma unroll
    for (int ks = 0; ks < NKS; ++ks) { float q[8], a[8], b2[8]; unpack8(*(const u32x4*)(sQ + t * QS + ks * 32 + g * 8), q);
#pragma unroll
        for (int e = 0; e < 8; ++e) { const int d = ks * 32 + g * 8 + e; const float bt = sB[t * BS + d]; r[ks][e] = (i == 0) ? 0.f : sB[(16 * i - 1) * BS + d]; a[e] = q[e] * expf(bt - r[ks][e]); b2[e] = q[e] * expf(bt); }
        qt[ks] = as_bf8(pack8(a)); qh[ks] = as_bf8(pack8(b2)); }
    f32x4 acc[4];
#pragma unroll
    for (int vt = 0; vt < 4; ++vt) { acc[vt] = (f32x4){0.f, 0.f, 0.f, 0.f};
#pragma unroll
        for (int ks = 0; ks < NKS; ++ks) acc[vt] = mfma16(*(const bf16x8*)(sS0 + (vt * 16 + fr) * QS + ks * 32 + g * 8), qh[ks], acc[vt]); }
    for (int jp = 0; jp <= i; jp += 2) {
        f32x4 aT[2];
#pragma unroll
        for (int jj = 0; jj < 2; ++jj) { const int j = jp + jj; aT[jj] = (f32x4){0.f, 0.f, 0.f, 0.f};
            if (j <= i) { const int s = 16 * j + fr;
#pragma unroll
                for (int ks = 0; ks < NKS; ++ks) { float kk[8]; unpack8(*(const u32x4*)(sK + s * QS + ks * 32 + g * 8), kk);
#pragma unroll
                    for (int e = 0; e < 8; ++e) kk[e] *= expf(r[ks][e] - sB[s * BS + ks * 32 + g * 8 + e]);
                    aT[jj] = mfma16(as_bf8(pack8(kk)), qt[ks], aT[jj]); }
                if (j == i) {
#pragma unroll
                    for (int e = 0; e < 4; ++e) if (g * 4 + e > fr) aT[jj][e] = 0.f; }
            } }
        u32x4 pb; pb.x = pk2(aT[0][0], aT[0][1]); pb.y = pk2(aT[0][2], aT[0][3]); pb.z = pk2(aT[1][0], aT[1][1]); pb.w = pk2(aT[1][2], aT[1][3]);
        const int j1 = (jp + 1 <= i) ? jp + 1 : jp;
#pragma unroll
        for (int vt = 0; vt < 4; ++vt) { u32x4 av; const u32x2 a0 = *(const u32x2*)(sVt + (vt * 16 + fr) * VS + 16 * jp + g * 4), a1 = *(const u32x2*)(sVt + (vt * 16 + fr) * VS + 16 * j1 + g * 4);
            av.x = a0.x; av.y = a0.y; av.z = a1.x; av.w = a1.y; acc[vt] = mfma16(as_bf8(av), as_bf8(pb), acc[vt]); }
    }
    float ss = 0.f;
#pragma unroll
    for (int vt = 0; vt < 4; ++vt) ss += (acc[vt][0] * acc[vt][0] + acc[vt][1] * acc[vt][1]) + (acc[vt][2] * acc[vt][2] + acc[vt][3] * acc[vt][3]);
    ss += __shfl_xor(ss, 16); ss += __shfl_xor(ss, 32);
    const float rms = rsqrtf(ss * (1.0f / 64.0f) + 1e-6f);
    const int row = n * SEQ + c * 128 + t;
#pragma unroll
    for (int vt = 0; vt < 4; ++vt) { const int v0 = vt * 16 + g * 4; const u32x2 gu = *(const u32x2*)(H + (size_t)row * NIN + (HG ? C_HG : C_RG) + h * 64 + v0);
        const float g0 = bflo(gu.x), g1 = bfhi(gu.x), g2 = bflo(gu.y), g3 = bfhi(gu.y); float w0 = rms, w1 = rms, w2 = rms, w3 = rms;
        if (HG) { const f32x4 nw = *(const f32x4*)(p.hg_norm_w + l * 64 + v0); w0 *= nw[0]; w1 *= nw[1]; w2 *= nw[2]; w3 *= nw[3]; }
        u32x2 o; o.x = pk2(acc[vt][0] * w0 * silu(g0), acc[vt][1] * w1 * silu(g1)); o.y = pk2(acc[vt][2] * w2 * silu(g2), acc[vt][3] * w3 * silu(g3));
        *(u32x2*)(CAT + (size_t)row * DM + (HG ? 256 : 0) + h * 64 + v0) = o; }
}

__device__ void swa_prompt_item(unsigned char* lds, const Params& p, int l, int n, int qb, int kvh) {
    constexpr int VT = 200;
    bf16_t* sK = (bf16_t*)lds; bf16_t* sVt = (bf16_t*)(lds + 27648); bf16_t* sQ = (bf16_t*)(lds + 53248);
    const bf16_t* H = (const bf16_t*)(p.ws + WS_R1); bf16_t* CAT = (bf16_t*)(p.ws + WS_CAT);
    const int tid = otid(), lane = tid & 63, wid = tid >> 6, fr = lane & 15, g = lane >> 4;
    const int q0 = qb * 64;
    __syncthreads();
#pragma unroll
    for (int it = 0; it < 3; ++it) { const int idx = tid + it * 512, key = idx >> 3, dg = idx & 7; const int pos = q0 - 128 + key;
        const bool ok = pos >= 0; const bf16_t* hr = H + (size_t)(n * SEQ + (ok ? pos : 0)) * NIN;
        const bool wr_cache = (qb >= 126) && (key >= 128);
        float* ok_out = p.out + O_PK + ((size_t)((l * 2 + n) * 128 + (pos - (SEQ - 128))) * 2 + kvh) * 64;
        float* ov_out = p.out + O_PV + ((size_t)((l * 2 + n) * 128 + (pos - (SEQ - 128))) * 2 + kvh) * 64;
        if (dg == 0) { float x1[8], x2[8], o1[8], o2[8];
            unpack8(*(const u32x4*)(hr + C_SK + kvh * 64), x1); unpack8(*(const u32x4*)(hr + C_SK + kvh * 64 + 8), x2);
#pragma unroll
            for (int j = 0; j < 8; ++j) { float sn, cs; sincos_red((float)pos * swa_inv(j), sn, cs); o1[j] = ok ? (x1[j] * cs - x2[j] * sn) : 0.f; o2[j] = ok ? (x2[j] * cs + x1[j] * sn) : 0.f; }
            *(u32x4*)(sK + key * QS) = pack8(o1); *(u32x4*)(sK + key * QS + 8) = pack8(o2);
            if (wr_cache) {
#pragma unroll
                for (int j = 0; j < 8; ++j) { ok_out[j] = bf2f(f2bf(o1[j])); ok_out[8 + j] = bf2f(f2bf(o2[j])); } }
        } else if (dg >= 2) { u32x4 kv = *(const u32x4*)(hr + C_SK + kvh * 64 + dg * 8); if (!ok) kv = (u32x4){0u, 0u, 0u, 0u}; *(u32x4*)(sK + key * QS + dg * 8) = kv;
            if (wr_cache) { float kk[8]; unpack8(kv, kk);
#pragma unroll
                for (int j = 0; j < 8; ++j) ok_out[dg * 8 + j] = kk[j]; } }
        { float vv[8]; unpack8(*(const u32x4*)(hr + C_SV + kvh * 64 + dg * 8), vv);
#pragma unroll
          for (int j = 0; j < 8; ++j) { sVt[(dg * 8 + j) * VT + key] = ok ? f2bf(vv[j]) : (bf16_t)0; if (wr_cache) ov_out[dg * 8 + j] = vv[j]; } }
    }
#pragma unroll
    for (int it = 0; it < 4; ++it) { const int idx = tid + it * 512, rw = idx >> 3, dg = idx & 7, hh = rw >> 6, iq = rw & 63; const int pos = q0 + iq;
        const bf16_t* hr = H + (size_t)(n * SEQ + pos) * NIN + C_SQ + (kvh * 4 + hh) * 64;
        if (dg == 0) { float x1[8], x2[8], o1[8], o2[8]; unpack8(*(const u32x4*)(hr), x1); unpack8(*(const u32x4*)(hr + 8), x2);
#pragma unroll
            for (int j = 0; j < 8; ++j) { float sn, cs; sincos_red((float)pos * swa_inv(j), sn, cs); o1[j] = (x1[j] * cs - x2[j] * sn) * 0.125f; o2[j] = (x2[j] * cs + x1[j] * sn) * 0.125f; }
            *(u32x4*)(sQ + rw * QS) = pack8(o1); *(u32x4*)(sQ + rw * QS + 8) = pack8(o2);
        } else if (dg >= 2) { float x[8]; unpack8(*(const u32x4*)(hr + dg * 8), x);
#pragma unroll
            for (int j = 0; j < 8; ++j) x[j] *= 0.125f;
            *(u32x4*)(sQ + rw * QS + dg * 8) = pack8(x); }
    }
    __syncthreads();
    const int hh = wid >> 1, qh = wid & 1; const float sink = p.sinks[l * 8 + kvh * 4 + hh];
    bf16x8 bq[2][2];
#pragma unroll
    for (int qt = 0; qt < 2; ++qt)
#pragma unroll
        for (int ks = 0; ks < 2; ++ks) bq[qt][ks] = *(const bf16x8*)(sQ + (hh * 64 + 32 * qh + 16 * qt + fr) * QS + ks * 32 + g * 8);
    f32x4 sT[10][2];
#pragma unroll
    for (int kt = 0; kt < 10; ++kt) { const int krow = 16 * (2 * qh + kt) + fr;
        const bf16x8 a0 = *(const bf16x8*)(sK + krow * QS + g * 8), a1 = *(const bf16x8*)(sK + krow * QS + 32 + g * 8);
#pragma unroll
        for (int qt = 0; qt < 2; ++qt) { f32x4 z = (f32x4){0.f, 0.f, 0.f, 0.f}; z = mfma16(a0, bq[qt][0], z); z = mfma16(a1, bq[qt][1], z); sT[kt][qt] = z; } }
    float mx[2] = {-INFINITY, -INFINITY};
#pragma unroll
    for (int kt = 0; kt < 10; ++kt)
#pragma unroll
        for (int qt = 0; qt < 2; ++qt)
#pragma unroll
            for (int e = 0; e < 4; ++e) { const int j = 16 * (2 * qh + kt) + g * 4 + e, iq = 32 * qh + 16 * qt + fr; const bool valid = (j >= iq) && (j <= iq + 128) && (q0 - 128 + j >= 0);
                const float s = valid ? sT[kt][qt][e] : -INFINITY; sT[kt][qt][e] = s; mx[qt] = fmaxf(mx[qt], s); }
    float den[2];
#pragma unroll
    for (int qt = 0; qt < 2; ++qt) { float m = mx[qt]; m = fmaxf(m, __shfl_xor(m, 16)); m = fmaxf(m, __shfl_xor(m, 32)); m = fmaxf(m, sink); mx[qt] = m; den[qt] = 0.f; }
#pragma unroll
    for (int kt = 0; kt < 10; ++kt)
#pragma unroll
        for (int qt = 0; qt < 2; ++qt)
#pragma unroll
            for (int e = 0; e < 4; ++e) { const float pe = expf(sT[kt][qt][e] - mx[qt]); sT[kt][qt][e] = pe; den[qt] += pe; }
#pragma unroll
    for (int qt = 0; qt < 2; ++qt) { float d = den[qt]; d += __shfl_xor(d, 16); d += __shfl_xor(d, 32); den[qt] = 1.0f / (d + expf(sink - mx[qt])); }
    f32x4 oT[4][2];
#pragma unroll
    for (int dt = 0; dt < 4; ++dt)
#pragma unroll
        for (int qt = 0; qt < 2; ++qt) oT[dt][qt] = (f32x4){0.f, 0.f, 0.f, 0.f};
#pragma unroll
    for (int kp = 0; kp < 5; ++kp) {
        u32x4 pb[2];
#pragma unroll
        for (int qt = 0; qt < 2; ++qt) { pb[qt].x = pk2(sT[2 * kp][qt][0], sT[2 * kp][qt][1]); pb[qt].y = pk2(sT[2 * kp][qt][2], sT[2 * kp][qt][3]); pb[qt].z = pk2(sT[2 * kp + 1][qt][0], sT[2 * kp + 1][qt][1]); pb[qt].w = pk2(sT[2 * kp + 1][qt][2], sT[2 * kp + 1][qt][3]); }
        const int kb = 16 * (2 * qh + 2 * kp);
#pragma unroll
        for (int dt = 0; dt < 4; ++dt) { const u32x2 a0 = *(const u32x2*)(sVt + (dt * 16 + fr) * VT + kb + g * 4), a1 = *(const u32x2*)(sVt + (dt * 16 + fr) * VT + kb + 16 + g * 4);
            u32x4 av; av.x = a0.x; av.y = a0.y; av.z = a1.x; av.w = a1.y;
#pragma unroll
            for (int qt = 0; qt < 2; ++qt) oT[dt][qt] = mfma16(as_bf8(av), as_bf8(pb[qt]), oT[dt][qt]); }
    }
#pragma unroll
    for (int qt = 0; qt < 2; ++qt) { const int row = n * SEQ + q0 + 32 * qh + 16 * qt + fr;
#pragma unroll
        for (int dt = 0; dt < 4; ++dt) { u32x2 o; o.x = pk2(oT[dt][qt][0] * den[qt], oT[dt][qt][1] * den[qt]); o.y = pk2(oT[dt][qt][2] * den[qt], oT[dt][qt][3] * den[qt]);
            *(u32x2*)(CAT + (size_t)row * DM + 512 + (kvh * 4 + hh) * 64 + dt * 16 + g * 4) = o; } }
}

template <int DK>
__device__ void sample_rec_item(unsigned char* lds, const Params& p, int l, int n, int h) {
    constexpr bool HG = (DK == 64); constexpr int PER = DK / 8;
    float* sq = (float*)lds; float* sk = sq + 256; float* sf = sk + 256; float* sv = sf + 256; float* spart = sv + 256;
    const bf16_t* H = (const bf16_t*)(p.ws + WS_R1); bf16_t* CAT = (bf16_t*)(p.ws + WS_CAT);
    const int tid = otid(), lane = tid & 63, wid = tid >> 6; const int row0 = TP + n * 4;
    __syncthreads();
    if (HG) {
        if (tid < 256) { const int t = tid >> 6, d = tid & 63; const bf16_t* hr = H + (size_t)(row0 + t) * NIN;
            const float hf = bf2f(hr[C_HF + h * 64 + d]); const float lb = lb_val(p.lb_raw, l, h * 64 + d); const float k = (1.0f - lb) / (1.0f + expf(hf));
            sk[t * 64 + d] = k; sf[t * 64 + d] = 1.0f - k; sq[t * 64 + d] = bf2f(hr[C_HQ + h * 64 + d]); }
        else { const int t = (tid - 256) >> 6, v = tid & 63; sv[t * 64 + v] = bf2f(H[(size_t)(row0 + t) * NIN + C_HI + h * 64 + v]); }
    } else {
        const float gam = 1.0f - exp2f(-5.0f - (float)h);
        if (tid < 64) { const int t = tid >> 4, i = tid & 15; const bf16_t* hr = H + (size_t)(row0 + t) * NIN; float sn, cs; sincos_red((float)(SEQ + t) * ret_inv(i), sn, cs);
            const float q1 = bf2f(hr[C_RQ + h * 32 + i]), q2 = bf2f(hr[C_RQ + h * 32 + 16 + i]), k1 = bf2f(hr[C_RK + h * 32 + i]), k2 = bf2f(hr[C_RK + h * 32 + 16 + i]);
            sq[t * 64 + i] = q1 * cs - q2 * sn; sq[t * 64 + 16 + i] = q2 * cs + q1 * sn;
            sk[t * 64 + i] = (k1 * cs - k2 * sn) * 0.17677669529663687f; sk[t * 64 + 16 + i] = (k2 * cs + k1 * sn) * 0.17677669529663687f;
            sf[t * 64 + i] = gam; sf[t * 64 + 16 + i] = gam; }
        if (tid >= 256) { const int t = (tid - 256) >> 6, v = tid & 63; sv[t * 64 + v] = bf2f(H[(size_t)(row0 + t) * NIN + C_RV + h * 64 + v]); }
    }
    __syncthreads();
    const int v = lane, dg = wid; float S[PER];
    const float* Sin = (HG ? p.state_hgrn : p.state_ret) + ((size_t)((l * 128 + n) * 4 + h) * DK) * 64;
    float* Sout = p.out + (HG ? O_SH : O_SR) + ((size_t)((l * 128 + n) * 4 + h) * DK) * 64;
#pragma unroll
    for (int i = 0; i < PER; ++i) S[i] = Sin[(dg * PER + i) * 64 + v];
#pragma unroll
    for (int t = 0; t < 4; ++t) { float part = 0.f; const float vv = sv[t * 64 + v];
#pragma unroll
        for (int i = 0; i < PER; ++i) { const int d = dg * PER + i; S[i] = sf[t * 64 + d] * S[i] + sk[t * 64 + d] * vv; part += sq[t * 64 + d] * S[i]; }
        spart[(t * 8 + dg) * 64 + v] = part; }
#pragma unroll
    for (int i = 0; i < PER; ++i) Sout[(dg * PER + i) * 64 + v] = S[i];
    __syncthreads();
    if (tid < 256) { const int t = wid; float o = 0.f;
#pragma unroll
        for (int k = 0; k < 8; ++k) o += spart[(t * 8 + k) * 64 + v];
        float ss = o * o;
#pragma unroll
        for (int m = 1; m < 64; m <<= 1) ss += __shfl_xor(ss, m);
        const float rms = rsqrtf(ss * (1.0f / 64.0f) + 1e-6f);
        const float gt = bf2f(H[(size_t)(row0 + t) * NIN + (HG ? C_HG : C_RG) + h * 64 + v]);
        float w = rms; if (HG) w *= p.hg_norm_w[l * 64 + v];
        CAT[(size_t)(row0 + t) * DM + (HG ? 256 : 0) + h * 64 + v] = f2bf(o * w * silu(gt)); }
}

__device__ void swa_sample_item(unsigned char* lds, const Params& p, int l, int n, int kvh) {
    float* sKa = (float*)lds; float* sVa = (float*)(lds + 34320); float* sQq = (float*)(lds + 68112); float* sP = (float*)(lds + 72208);
    const bf16_t* H = (const bf16_t*)(p.ws + WS_R1); bf16_t* CAT = (bf16_t*)(p.ws + WS_CAT);
    const int tid = otid(), lane = tid & 63, wid = tid >> 6; const int row0 = TP + n * 4;
    __syncthreads();
    const size_t cbase = (size_t)(l * 128 + n) * 128 * 128;
    for (int idx = tid; idx < 128 * 64; idx += 512) { const int j = idx >> 6, d = idx & 63; sKa[j * 65 + d] = p.cache_k[cbase + (size_t)(j * 2 + kvh) * 64 + d]; sVa[j * 64 + d] = p.cache_v[cbase + (size_t)(j * 2 + kvh) * 64 + d]; }
    if (tid < 256) { const int t = tid >> 6, d = tid & 63; const bf16_t* hr = H + (size_t)(row0 + t) * NIN;
        sVa[(128 + t) * 64 + d] = bf2f(hr[C_SV + kvh * 64 + d]);
        if (d >= 16) sKa[(128 + t) * 65 + d] = bf2f(hr[C_SK + kvh * 64 + d]);
        else if (d < 8) { float sn, cs; sincos_red((float)(SEQ + t) * swa_inv(d), sn, cs); const float x1 = bf2f(hr[C_SK + kvh * 64 + d]), x2 = bf2f(hr[C_SK + kvh * 64 + 8 + d]);
            sKa[(128 + t) * 65 + d] = x1 * cs - x2 * sn; sKa[(128 + t) * 65 + 8 + d] = x2 * cs + x1 * sn; } }
    for (int idx = tid; idx < 16 * 64; idx += 512) { const int r = idx >> 6, d = idx & 63, t = r >> 2, hh = r & 3; const bf16_t* hr = H + (size_t)(row0 + t) * NIN + C_SQ + (kvh * 4 + hh) * 64;
        if (d >= 16) sQq[r * 64 + d] = bf2f(hr[d]);
        else if (d < 8) { float sn, cs; sincos_red((float)(SEQ + t) * swa_inv(d), sn, cs); const float x1 = bf2f(hr[d]), x2 = bf2f(hr[8 + d]); sQq[r * 64 + d] = x1 * cs - x2 * sn; sQq[r * 64 + 8 + d] = x2 * cs + x1 * sn; } }
    __syncthreads();
    for (int pi = tid; pi < 16 * 132; pi += 512) { const int r = pi / 132, j = pi % 132, t = r >> 2; float s = 0.f;
#pragma unroll 16
        for (int d = 0; d < 64; ++d) s += sQq[r * 64 + d] * sKa[j * 65 + d];
        sP[r * 136 + j] = (j >= t && j <= t + 128) ? s * 0.125f : -INFINITY; }
    __syncthreads();
#pragma unroll
    for (int rr = 0; rr < 2; ++rr) { const int r = wid * 2 + rr, hh = r & 3; const float sink = p.sinks[l * 8 + kvh * 4 + hh];
        const float s0 = sP[r * 136 + lane], s1 = sP[r * 136 + 64 + lane], s2 = (lane < 4) ? sP[r * 136 + 128 + lane] : -INFINITY;
        float m = fmaxf(fmaxf(s0, s1), s2);
#pragma unroll
        for (int o = 1; o < 64; o <<= 1) m = fmaxf(m, __shfl_xor(m, o));
        m = fmaxf(m, sink);
        const float p0 = expf(s0 - m), p1 = expf(s1 - m), p2 = expf(s2 - m); float dsum = p0 + p1 + p2;
#pragma unroll
        for (int o = 1; o < 64; o <<= 1) dsum += __shfl_xor(dsum, o);
        const float inv = 1.0f / (dsum + expf(sink - m));
        sP[r * 136 + lane] = p0 * inv; sP[r * 136 + 64 + lane] = p1 * inv; if (lane < 4) sP[r * 136 + 128 + lane] = p2 * inv; }
    __syncthreads();
#pragma unroll
    for (int rr = 0; rr < 2; ++rr) { const int r = wid + rr * 8, d = lane, t = r >> 2, hh = r & 3; float o = 0.f;
        for (int j = 0; j < 132; ++j) o += sP[r * 136 + j] * sVa[j * 64 + d];
        CAT[(size_t)(row0 + t) * DM + 512 + (kvh * 4 + hh) * 64 + d] = f2bf(o); }
    for (int idx = tid; idx < 128 * 64; idx += 512) { const int j = idx >> 6, d = idx & 63; const size_t o = cbase + (size_t)(j * 2 + kvh) * 64 + d;
        p.out[O_SK + o] = sKa[(j + 4) * 65 + d]; p.out[O_SV + o] = sVa[(j + 4) * 64 + d]; }
}

__device__ void mix_a_phase(unsigned char* lds, const Params& p, int l) {
    for (int it = blockIdx.x; it < 2816; it += gridDim.x) {
        if (it < 512) { swa_prompt_item(lds, p, l, it >> 8, (it >> 1) & 127, it & 1); }
        else if (it < 1536) { const int k = it - 512, ty = k >> 9, n = (k >> 8) & 1, h = (k >> 6) & 3, c = k & 63;
            if (ty == 0) local_state_item<64>(lds, p, l, n, h, c); else local_state_item<32>(lds, p, l, n, h, c); }
        else if (it < 2560) { const int k = it - 1536, ty = k >> 9, n = (k >> 2) & 127, h = k & 3;
            if (ty == 0) sample_rec_item<64>(lds, p, l, n, h); else sample_rec_item<32>(lds, p, l, n, h); }
        else { const int k = it - 2560; swa_sample_item(lds, p, l, k >> 1, k & 1); }
    }
}
__device__ void mix_c_phase(unsigned char* lds, const Params& p, int l) {
    for (int it = blockIdx.x; it < 1024; it += gridDim.x) { const int ty = it >> 9, n = (it >> 8) & 1, h = (it >> 6) & 3, c = it & 63;
        if (ty == 0) chunk_out_item<64>(lds, p, l, n, h, c); else chunk_out_item<32>(lds, p, l, n, h, c); }
}

__global__ void __launch_bounds__(NT) fwd_megakernel(Params p) {
    extern __shared__ __attribute__((aligned(16))) unsigned char lds[];
    cg::grid_group grid = cg::this_grid();
    PG8_LAS unsigned char* L = (PG8_LAS unsigned char*)lds;
    bf16_t* Xb = (bf16_t*)(p.ws + WS_XB); bf16_t* H = (bf16_t*)(p.ws + WS_R1); bf16_t* CAT = (bf16_t*)(p.ws + WS_CAT); float* X = p.out;
    prep_phase(lds, p);
    grid.sync();
#pragma unroll 1
    for (int l = 0; l < 4; ++l) {
        { const bf16_t* W = (const bf16_t*)(p.ws + WS_WIN) + (size_t)l * NIN * DM;
          pg8::StaticOrder S; S.init(TP, NIN, (int)gridDim.x, (int)blockIdx.x);
          pg8::gemm_phase<pg8::EpiB16<0>, pg8::StaticOrder>(L, pg8::Gemm{Xb, W, TP, NIN, DM}, S, pg8::EpiB16<0>{H, NIN}, nullptr);
          small_gemm<NIN, DM>(lds, Xb + (size_t)TP * DM, W, EpiH{H}); }
        grid.sync();
        mix_a_phase(lds, p, l);
        grid.sync();
        scan_phase(p, l);
        grid.sync();
        mix_c_phase(lds, p, l);
        grid.sync();
        { const bf16_t* W = (const bf16_t*)(p.ws + WS_WOUT) + (size_t)l * DM * DM;
          pg8::StaticOrder S; S.init(TP, DM, (int)gridDim.x, (int)blockIdx.x);
          pg8::gemm_phase<pg8::EpiResF32, pg8::StaticOrder>(L, pg8::Gemm{CAT, W, TP, DM, DM}, S, pg8::EpiResF32{X, DM, ALPHA}, nullptr);
          small_gemm<DM, DM>(lds, CAT + (size_t)TP * DM, W, EpiRes{X}); }
        grid.sync();
        ln_phase(X, Xb, p.ln_mix_g + l * DM, p.ln_mix_b + l * DM);
        grid.sync();
        { const bf16_t* W = (const bf16_t*)(p.ws + WS_WUP) + (size_t)l * DFF * DM;
          pg8::StaticOrder S; S.init(TP, DFF, (int)gridDim.x, (int)blockIdx.x);
          pg8::gemm_phase<pg8::EpiB16<1>, pg8::StaticOrder>(L, pg8::Gemm{Xb, W, TP, DFF, DM}, S, pg8::EpiB16<1>{H, DFF}, nullptr);
          small_gemm<DFF, DM>(lds, Xb + (size_t)TP * DM, W, EpiRelu2{H}); }
        grid.sync();
        { const bf16_t* W = (const bf16_t*)(p.ws + WS_WDN) + (size_t)l * DM * DFF;
          pg8::StaticOrder S; S.init(TP, DM, (int)gridDim.x, (int)blockIdx.x);
          pg8::gemm_phase<pg8::EpiResF32, pg8::StaticOrder>(L, pg8::Gemm{H, W, TP, DM, DFF}, S, pg8::EpiResF32{X, DM, ALPHA}, nullptr);
          small_gemm<DM, DFF>(lds, H + (size_t)TP * DFF, W, EpiRes{X}); }
        grid.sync();
        ln_phase(X, Xb, p.ln_ffn_g + l * DM, p.ln_ffn_b + l * DM);
        grid.sync();
    }
}

extern "C" void kernel_launch(void* const* d_in, const int* in_sizes, int n_in, void* d_out, int out_size, void* d_ws, size_t ws_size, hipStream_t stream) {
    static int grid_blocks = 0;
    if (!grid_blocks) {
        int dev = 0, cus = 0, per_cu = 0;
        hipGetDevice(&dev);
        hipDeviceGetAttribute(&cus, hipDeviceAttributeMultiprocessorCount, dev);
        hipFuncSetAttribute((const void*)fwd_megakernel, hipFuncAttributeMaxDynamicSharedMemorySize, LDS_BYTES);
        hipOccupancyMaxActiveBlocksPerMultiprocessor(&per_cu, (const void*)fwd_megakernel, NT, LDS_BYTES);
        if (per_cu < 1) per_cu = 1;
        grid_blocks = cus * per_cu;
        if (ws_size < WS_END) fprintf(stderr, "workspace too small: %zu < %zu\n", ws_size, (size_t)WS_END);
    }
    Params p{};
    p.x_prompt = (const float*)d_in[0]; p.x_sample = (const float*)d_in[1]; p.state_ret = (const float*)d_in[2]; p.state_hgrn = (const float*)d_in[3];
    p.cache_k = (const float*)d_in[4]; p.cache_v = (const float*)d_in[5]; p.w_in = (const float*)d_in[6]; p.w_out = (const float*)d_in[7];
    p.sinks = (const float*)d_in[8]; p.lb_raw = (const float*)d_in[9]; p.hg_norm_w = (const float*)d_in[10]; p.ln_mix_g = (const float*)d_in[11];
    p.ln_mix_b = (const float*)d_in[12]; p.w_up = (const float*)d_in[13]; p.w_down = (const float*)d_in[14]; p.ln_ffn_g = (const float*)d_in[15]; p.ln_ffn_b = (const float*)d_in[16];
    p.out = (float*)d_out; p.ws = (unsigned char*)d_ws;
    void* args[] = {&p};
    hipError_t e = hipLaunchCooperativeKernel((const void*)fwd_megakernel, dim3(grid_blocks), dim3(NT), args, LDS_BYTES, stream);
    if (e != hipSuccess) fprintf(stderr, "cooperative launch failed: %s (grid %d)\n", hipGetErrorString(e), grid_blocks);
}
```

```cpp
#include <hip/hip_runtime.h>
#include <hip/hip_cooperative_groups.h>
#include <cstdio>
namespace cg = cooperative_groups;

typedef unsigned short bf16_t;
typedef short bf16x8 __attribute__((ext_vector_type(8)));
typedef float f32x4 __attribute__((ext_vector_type(4)));
typedef unsigned u32x4 __attribute__((ext_vector_type(4)));
typedef unsigned u32x2 __attribute__((ext_vector_type(2)));

constexpr int NT = 512;
constexpr int DM = 1024, TP = 16384, TS = 512, TT = 16896, SEQ = 8192, NIN = 2560, DFF = 4096;
constexpr int C_RQ = 0, C_RK = 128, C_RV = 256, C_RG = 512, C_HQ = 768, C_HF = 1024, C_HI = 1280, C_HG = 1536, C_SQ = 1792, C_SK = 2304, C_SV = 2432;
constexpr float ALPHA = 1.6817928305074290f;
constexpr size_t O_YP = 0, O_YS = 16777216, O_PR = 17301504, O_PH = 17367040, O_PK = 17498112, O_PV = 17629184,
                 O_SR = 17760256, O_SH = 21954560, O_SK = 30343168, O_SV = 38731776;
constexpr size_t WS_WIN = 0, WS_WOUT = WS_WIN + 20971520, WS_WUP = WS_WOUT + 8388608, WS_WDN = WS_WUP + 33554432,
                 WS_XB = WS_WDN + 33554432, WS_R1 = WS_XB + 34603008, WS_CAT = WS_R1 + 86507520,
                 WS_SLR = WS_R1 + 138412032, WS_SLH = WS_SLR + 4194304, WS_SIR = WS_SLH + 8388608, WS_SIH = WS_SIR + 4194304,
                 WS_DEC = WS_SIH + 8388608, WS_BAR = WS_DEC + 131072, WS_END = WS_BAR + 16384;
constexpr int LDS_BYTES = 131072 + 16;

struct Params {
    const float *x_prompt, *x_sample, *state_ret, *state_hgrn, *cache_k, *cache_v, *w_in, *w_out, *sinks, *lb_raw, *hg_norm_w,
                *ln_mix_g, *ln_mix_b, *w_up, *w_down, *ln_ffn_g, *ln_ffn_b;
    float* out; unsigned char* ws;
};

__device__ __forceinline__ unsigned pk2(float lo, float hi) { unsigned r; asm("v_cvt_pk_bf16_f32 %0, %1, %2" : "=v"(r) : "v"(lo), "v"(hi)); return r; }
__device__ __forceinline__ float bflo(unsigned u) { return __uint_as_float(u << 16); }
__device__ __forceinline__ float bfhi(unsigned u) { return __uint_as_float(u & 0xffff0000u); }
__device__ __forceinline__ float bf2f(bf16_t h) { return __uint_as_float((unsigned)h << 16); }
__device__ __forceinline__ bf16_t f2bf(float f) { return (bf16_t)(pk2(f, 0.f) & 0xffffu); }
__device__ __forceinline__ void unpack8(u32x4 u, float* f) { f[0] = bflo(u.x); f[1] = bfhi(u.x); f[2] = bflo(u.y); f[3] = bfhi(u.y); f[4] = bflo(u.z); f[5] = bfhi(u.z); f[6] = bflo(u.w); f[7] = bfhi(u.w); }
__device__ __forceinline__ u32x4 pack8(const float* f) { u32x4 u; u.x = pk2(f[0], f[1]); u.y = pk2(f[2], f[3]); u.z = pk2(f[4], f[5]); u.w = pk2(f[6], f[7]); return u; }
__device__ __forceinline__ bf16x8 as_bf8(u32x4 u) { return __builtin_bit_cast(bf16x8, u); }
__device__ __forceinline__ f32x4 mfma16(bf16x8 a, bf16x8 b, f32x4 c) { return __builtin_amdgcn_mfma_f32_16x16x32_bf16(a, b, c, 0, 0, 0); }
__device__ __forceinline__ void sincos_red(float a, float& s, float& c) {
    float k = rintf(a * 0.15915494309189535f);
    float r = fmaf(-k, 6.2831854820251465f, a);
    r = fmaf(k, 1.7484555e-7f, r);
    s = __sinf(r); c = __cosf(r);
}
__device__ __forceinline__ float ret_inv(int i) { return exp2f(-(float)i * 0.88584749f); }
__device__ __forceinline__ float swa_inv(int i) { return exp2f(-(float)i * 2.36644607f); }
__device__ __forceinline__ float ret_lg(int h) { return logf(1.0f - exp2f(-5.0f - (float)h)); }
__device__ __forceinline__ float lb_val(const float* raw, int l, int col) {
    float r0 = raw[col], r1 = raw[256 + col], r2 = raw[512 + col], r3 = raw[768 + col];
    float m = fmaxf(fmaxf(r0, r1), fmaxf(r2, r3));
    float e0 = expf(r0 - m), e1 = expf(r1 - m), e2 = expf(r2 - m), e3 = expf(r3 - m);
    float s = e0 + e1 + e2 + e3, a = 0.f;
    if (l >= 1) a += e1; if (l >= 2) a += e2; if (l >= 3) a += e3;
    return a / s;
}
__device__ __forceinline__ int otid() { int t = threadIdx.x; asm volatile("" : "+v"(t)); return t; }
__device__ __forceinline__ float silu(float g) { return g / (1.0f + expf(-g)); }

#define XB_TMO      128
#define XB_XCNT(j)  (256  + 64 * (j))
#define XB_XSUB(j)  (1280 + 64 * (j))
#define XB_XGEN(j)  (2304 + 64 * (j))
#define XB_TOP      3328
#define XB_TOPGEN   3392
#define XCD_BAR_WORDS 3456
#define XB_SPIN_CAP (1u << 18)
#define LAS __attribute__((address_space(3)))

__device__ __forceinline__ unsigned xb_ld(unsigned* p)              { return __hip_atomic_load(p, __ATOMIC_RELAXED, __HIP_MEMORY_SCOPE_AGENT); }
__device__ __forceinline__ unsigned xb_add(unsigned* p, unsigned v) { return __hip_atomic_fetch_add(p, v, __ATOMIC_RELAXED, __HIP_MEMORY_SCOPE_AGENT); }
__device__ __forceinline__ unsigned xb_xcc_id() { return (unsigned)__builtin_amdgcn_s_getreg((3 << 11) | 20) & 0xFu; }
#define XB_SPIN(cond, bar) do { unsigned _sp = 0; while (cond) { __builtin_amdgcn_s_sleep(1); \
    if ((++_sp & 255u) == 0u) { if (xb_ld(&(bar)[XB_TMO])) break; if (_sp > XB_SPIN_CAP) { atomicAdd(&(bar)[XB_TMO], 1u); break; } } } } while (0)

struct XcdBarrier {
    unsigned* bar; unsigned x;
    volatile LAS unsigned* st;
};

__device__ __forceinline__ XcdBarrier xcd_barrier_post(unsigned* bar, volatile LAS unsigned* st) {
    XcdBarrier b; b.bar = bar; b.x = xb_xcc_id(); b.st = st;
    if (threadIdx.x == 0) (void)xb_add(&bar[XB_XCNT(b.x)], 1u);
    return b;
}
__device__ __forceinline__ void xcd_barrier_complete(unsigned* bar, unsigned x, unsigned& nloc, unsigned& nx) {
    const unsigned G = gridDim.x * gridDim.y * gridDim.z;
    unsigned sum, cnt, mine, sp = 0u;
    for (;;) {
        sum = 0u; cnt = 0u; mine = 0u;
#pragma unroll
        for (unsigned j = 0; j < 16; ++j) { const unsigned c = xb_ld(&bar[XB_XCNT(j)]); sum += c; cnt += (c > 0u) ? 1u : 0u; mine = (j == x) ? c : mine; }
        if (sum == G) break;
        __builtin_amdgcn_s_sleep(1);
        if ((++sp & 255u) == 0u) { if (xb_ld(&bar[XB_TMO])) break; if (sp > XB_SPIN_CAP) { atomicAdd(&bar[XB_TMO], 1u); break; } }
    }
    nloc = mine > 0u ? mine : 1u; nx = cnt > 0u ? cnt : 1u;
}

__device__ __forceinline__ void xcd_barrier(const XcdBarrier& b) {
    asm volatile("s_waitcnt vmcnt(0)" ::: "memory");
    __syncthreads();
    if (threadIdx.x == 0) {
        unsigned* bar = b.bar;
        __builtin_amdgcn_s_waitcnt(0);
        unsigned nloc = b.st[0], nx = b.st[1];
        if (nloc == 0u) { xcd_barrier_complete(bar, b.x, nloc, nx); b.st[0] = nloc; b.st[1] = nx; }
        const unsigned old = xb_add(&bar[XB_XSUB(b.x)], 1u);
        const unsigned gen = old / nloc;
        if (old + 1u == (gen + 1u) * nloc) {
            __builtin_amdgcn_fence(__ATOMIC_RELEASE, "agent");
            asm volatile("s_waitcnt vmcnt(0)" ::: "memory");
            const unsigned og = xb_add(&bar[XB_TOP], 1u);
            const unsigned tg = og / nx;
            if (og + 1u == (tg + 1u) * nx) xb_add(&bar[XB_TOPGEN], 1u);
            else XB_SPIN(xb_ld(&bar[XB_TOPGEN]) == tg, bar);
            __builtin_amdgcn_fence(__ATOMIC_ACQUIRE, "agent");
            xb_add(&bar[XB_XGEN(b.x)], 1u);
            asm volatile("s_waitcnt vmcnt(0)" ::: "memory");
        } else {
            XB_SPIN(xb_ld(&bar[XB_XGEN(b.x)]) == gen, bar);
            __builtin_amdgcn_fence(__ATOMIC_ACQUIRE, "agent");
            asm volatile("s_waitcnt vmcnt(0)" ::: "memory");
        }
    }
    __syncthreads();
}


__device__ void transpose_convert(unsigned char* lds, const float* __restrict__ W, bf16_t* __restrict__ Wt, int K, int N) {
    float* tile = (float*)lds;
    const int tid = otid(), tn = N / 64, nt = (K / 64) * tn;
    for (int u = blockIdx.x; u < nt; u += gridDim.x) {
        const int k0 = (u / tn) * 64, n0 = (u % tn) * 64;
        __syncthreads();
#pragma unroll
        for (int i = 0; i < 2; ++i) { const int idx = tid + i * 512, r = idx >> 4, c4 = (idx & 15) * 4;
            const float4 v = *(const float4*)(W + (size_t)(k0 + r) * N + n0 + c4);
            tile[r * 65 + c4] = v.x; tile[r * 65 + c4 + 1] = v.y; tile[r * 65 + c4 + 2] = v.z; tile[r * 65 + c4 + 3] = v.w; }
        __syncthreads();
        const int n = tid >> 3, kk = (tid & 7) * 8; float f[8];
#pragma unroll
        for (int j = 0; j < 8; ++j) f[j] = tile[(kk + j) * 65 + n];
        *(u32x4*)(Wt + (size_t)(n0 + n) * K + k0 + kk) = pack8(f);
    }
}
__device__ void prep_phase(unsigned char* lds, const Params& p) {
    for (int l = 0; l < 4; ++l) {
        transpose_convert(lds, p.w_in + (size_t)l * DM * NIN, (bf16_t*)(p.ws + WS_WIN) + (size_t)l * NIN * DM, DM, NIN);
        transpose_convert(lds, p.w_out + (size_t)l * DM * DM, (bf16_t*)(p.ws + WS_WOUT) + (size_t)l * DM * DM, DM, DM);
        transpose_convert(lds, p.w_up + (size_t)l * DM * DFF, (bf16_t*)(p.ws + WS_WUP) + (size_t)l * DFF * DM, DM, DFF);
        transpose_convert(lds, p.w_down + (size_t)l * DFF * DM, (bf16_t*)(p.ws + WS_WDN) + (size_t)l * DM * DFF, DFF, DM);
    }
    float* X = p.out; bf16_t* Xb = (bf16_t*)(p.ws + WS_XB);
    const size_t n4 = (size_t)TT * DM / 4, np4 = (size_t)TP * DM / 4;
    for (size_t i = (size_t)blockIdx.x * NT + threadIdx.x; i < n4; i += (size_t)gridDim.x * NT) {
        const float4 v = (i < np4) ? ((const float4*)p.x_prompt)[i] : ((const float4*)p.x_sample)[i - np4];
        ((float4*)X)[i] = v; u32x2 w; w.x = pk2(v.x, v.y); w.y = pk2(v.z, v.w); ((u32x2*)Xb)[i] = w;
    }
}

struct EpiH { bf16_t* H; __device__ __forceinline__ void operator()(int row, int col, f32x4 v) const { u32x2 w; w.x = pk2(v[0], v[1]); w.y = pk2(v[2], v[3]); *(u32x2*)(H + (size_t)row * NIN + col) = w; } };
struct EpiRes { float* X; __device__ __forceinline__ void operator()(int row, int col, f32x4 v) const { f32x4* q = (f32x4*)(X + (size_t)row * DM + col); *q = *q * ALPHA + v; } };
struct EpiRelu2 { bf16_t* HF; __device__ __forceinline__ void operator()(int row, int col, f32x4 v) const { u32x2 w; float a = fmaxf(v[0], 0.f), b = fmaxf(v[1], 0.f), c = fmaxf(v[2], 0.f), d = fmaxf(v[3], 0.f); w.x = pk2(a * a, b * b); w.y = pk2(c * c, d * d); *(u32x2*)(HF + (size_t)row * DFF + col) = w; } };

template <class Epi>
__device__ void gemm_phase(unsigned char* lds, const bf16_t* __restrict__ A, const bf16_t* __restrict__ Bt, int M, int N, int K, const Epi& epi) {
    constexpr int BM = 256, BN = 128, BK = 64, LS = 72;
    bf16_t* sA = (bf16_t*)lds; bf16_t* sB = sA + BM * LS;
    const int tid = otid(), lane = tid & 63, wid = tid >> 6, fr = lane & 15, g = lane >> 4, wr = wid >> 1, wc = wid & 1;
    const int nN = N / BN, units = (M / BM) * nN;
    for (int u = blockIdx.x; u < units; u += gridDim.x) {
        const int pm = u / nN, pn = u % nN;
        const bf16_t* Ab = A + (size_t)pm * BM * K; const bf16_t* Bb = Bt + (size_t)pn * BN * K;
        f32x4 acc[4][4];
#pragma unroll
        for (int a = 0; a < 4; ++a)
#pragma unroll
            for (int b = 0; b < 4; ++b) acc[a][b] = (f32x4){0.f, 0.f, 0.f, 0.f};
        u32x4 ra[4], rb[2];
#pragma unroll
        for (int i = 0; i < 4; ++i) { const int idx = tid + i * 512; ra[i] = *(const u32x4*)(Ab + (size_t)(idx >> 3) * K + (idx & 7) * 8); }
#pragma unroll
        for (int i = 0; i < 2; ++i) { const int idx = tid + i * 512; rb[i] = *(const u32x4*)(Bb + (size_t)(idx >> 3) * K + (idx & 7) * 8); }
        for (int k0 = 0; k0 < K; k0 += BK) {
            __syncthreads();
#pragma unroll
            for (int i = 0; i < 4; ++i) { const int idx = tid + i * 512; *(u32x4*)(sA + (idx >> 3) * LS + (idx & 7) * 8) = ra[i]; }
#pragma unroll
            for (int i = 0; i < 2; ++i) { const int idx = tid + i * 512; *(u32x4*)(sB + (idx >> 3) * LS + (idx & 7) * 8) = rb[i]; }
            __syncthreads();
            if (k0 + BK < K) {
#pragma unroll
                for (int i = 0; i < 4; ++i) { const int idx = tid + i * 512; ra[i] = *(const u32x4*)(Ab + (size_t)(idx >> 3) * K + k0 + BK + (idx & 7) * 8); }
#pragma unroll
                for (int i = 0; i < 2; ++i) { const int idx = tid + i * 512; rb[i] = *(const u32x4*)(Bb + (size_t)(idx >> 3) * K + k0 + BK + (idx & 7) * 8); }
            }
#pragma unroll
            for (int ks = 0; ks < 2; ++ks) {
                bf16x8 af[4], bfr[4];
#pragma unroll
                for (int m = 0; m < 4; ++m) af[m] = *(const bf16x8*)(sA + (wr * 64 + m * 16 + fr) * LS + ks * 32 + g * 8);
#pragma unroll
                for (int n = 0; n < 4; ++n) bfr[n] = *(const bf16x8*)(sB + (wc * 64 + n * 16 + fr) * LS + ks * 32 + g * 8);
#pragma unroll
                for (int m = 0; m < 4; ++m)
#pragma unroll
                    for (int n = 0; n < 4; ++n) acc[m][n] = mfma16(bfr[n], af[m], acc[m][n]);
            }
        }
#pragma unroll
        for (int m = 0; m < 4; ++m)
#pragma unroll
            for (int n = 0; n < 4; ++n) epi(pm * BM + wr * 64 + m * 16 + fr, pn * BN + wc * 64 + n * 16 + g * 4, acc[m][n]);
    }
}

namespace pg8 {
#define PG8_LAS __attribute__((address_space(3)))
typedef unsigned short bf16_t;
typedef short bf16x8 __attribute__((ext_vector_type(8)));
typedef float f32x4 __attribute__((ext_vector_type(4)));
typedef unsigned u32x4 __attribute__((ext_vector_type(4)));
constexpr int BM = 256, BK = 64, HALF = 128, HTB = HALF * BK * 2  , STAGE_BYTES = 8 * HTB, NXCD = 8, WGM = 8;

__host__ __device__ __forceinline__ int lds_byte(int r, int c) { const int st = (r >> 4) * 2 + (c >> 5), rr = r & 15, cc = c & 31, ob = rr * 64 + cc * 2; return st * 1024 + (ob ^ (((ob >> 9) & 1) << 5)); }
__host__ __device__ __forceinline__ void stage_rc(int b, int& R, int& C) { const int st = b / 1024, sb = b % 1024, swz = sb ^ (((sb >> 9) & 1) << 5); R = (st >> 1) * 16 + swz / 64; C = (st & 1) * 32 + (swz % 64) / 2; }
__host__ __device__ __forceinline__ int perm32(int rho) { const int n = rho >> 4, i = rho & 15; return 8 * (i >> 2) + 4 * n + (i & 3); }

struct Unit { int pm, pn; };
struct Gemm { const bf16_t* A; const bf16_t* Bt; int M, N, K; };

struct StaticOrder {
    int nM, nN, nwg, G, c;
    __host__ __device__ void init(int M, int N, int G_, int c_) { nM = M / BM; nN = N / BM; nwg = nM * nN; G = G_; c = c_; }
    __host__ __device__ bool next(int i, Unit& u) const {
        const long L = (long)i * G + c; if (L >= nwg) return false;
        int wgid = (int)L; { const int q = nwg / NXCD, r = nwg % NXCD, xcd = wgid % NXCD, off = wgid / NXCD; wgid = (xcd < r ? xcd * (q + 1) : r * (q + 1) + (xcd - r) * q) + off; }
        const int nig = WGM * nN, gid = wgid / nig, fm = gid * WGM, gsz = (nM - fm) < WGM ? (nM - fm) : WGM;
        u.pm = fm + ((wgid % nig) % gsz); u.pn = (wgid % nig) / gsz; return true;
    }
    __device__ __forceinline__ void a_ready(const Unit&) const {}
    __device__ __forceinline__ void done(const Unit&) const {}
};

__device__ __forceinline__ unsigned cvt_pk_bf16(float lo, float hi) { unsigned r; asm volatile("v_cvt_pk_bf16_f32 %0, %1, %2" : "=v"(r) : "v"(lo), "v"(hi)); return r; }
template <int ACT  > struct EpiB16 {
    static constexpr bool PERM = true, AFTER_DRAIN = false;
    bf16_t* O; int ldc;
    __device__ __forceinline__ void operator()(const f32x4 (&acc)[2][2][4][2], const Unit& u, int wr, int wc, int fr, int fq) const {
        const int row0 = u.pm * BM + wr * 64 + fr, col0 = u.pn * BM + wc * 32 + 8 * fq;
#pragma unroll
        for (int ai = 0; ai < 2; ++ai)
#pragma unroll
            for (int m = 0; m < 4; ++m) { bf16_t* rowp = O + (size_t)(row0 + ai * HALF + m * 16) * ldc + col0;
#pragma unroll
                for (int bj = 0; bj < 2; ++bj) { f32x4 v0 = acc[ai][bj][m][0], v1 = acc[ai][bj][m][1];
                    if (ACT == 1) {
#pragma unroll
                        for (int j = 0; j < 4; ++j) { const float a = fmaxf(v0[j], 0.f), b = fmaxf(v1[j], 0.f); v0[j] = a * a; v1[j] = b * b; } }
                    u32x4 w; w.x = cvt_pk_bf16(v0[0], v0[1]); w.y = cvt_pk_bf16(v0[2], v0[3]); w.z = cvt_pk_bf16(v1[0], v1[1]); w.w = cvt_pk_bf16(v1[2], v1[3]);
                    *(u32x4*)(rowp + bj * HALF) = w; } }
    }
};
struct EpiResF32 {
    static constexpr bool PERM = false, AFTER_DRAIN = false;
    float* X; int ldc; float alpha;
    __device__ __forceinline__ void operator()(const f32x4 (&acc)[2][2][4][2], const Unit& u, int wr, int wc, int fr, int fq) const {
        const int row0 = u.pm * BM + wr * 64 + fr, col0 = u.pn * BM + wc * 32 + 4 * fq;
#pragma unroll
        for (int ai = 0; ai < 2; ++ai)
#pragma unroll
            for (int m = 0; m < 4; ++m) { float* rowp = X + (size_t)(row0 + ai * HALF + m * 16) * ldc + col0;
#pragma unroll
                for (int bj = 0; bj < 2; ++bj)
#pragma unroll
                    for (int n = 0; n < 2; ++n) { f32x4* q = (f32x4*)(rowp + bj * HALF + n * 16); *q = *q * alpha + acc[ai][bj][m][n]; } }
    }
};
template <class Epi, class Sched, bool STAMP = false>
__device__ __forceinline__ void gemm_phase(PG8_LAS unsigned char* lds, const Gemm g, const Sched& S, const Epi& E, unsigned long long* stamps) {
    int tid = threadIdx.x; asm volatile("" : "+v"(tid)); const int wid = __builtin_amdgcn_readfirstlane(tid >> 6), lane = tid & 63, wr = wid >> 2, wc = wid & 3, fr = lane & 15, fq = lane >> 4;
    const int K = g.K, nt = K / BK;
    int ts_lo = 0, ts_hi = 0, nts = 0; const unsigned long long rt_entry = STAMP ? (unsigned long long)wall_clock64() : 0ull;
#define PG8_STAMP() do { if (STAMP && wid == 0 && nts < 64) { const unsigned long long _c = (unsigned long long)clock64(); \
        ts_lo = (lane == nts) ? (int)(unsigned)_c : ts_lo; ts_hi = (lane == nts) ? (int)(unsigned)(_c >> 32) : ts_hi; ++nts; } } while (0)
    PG8_STAMP();
    unsigned voffA[2], voffB[2];
#pragma unroll
    for (int i = 0; i < 2; ++i) { int R, C; stage_rc(tid * 16 + i * 8192, R, C); const int Rb = Epi::PERM ? ((R & ~31) + perm32(R & 31)) : R;
        voffA[i] = (unsigned)(R * K + C) * 2u; voffB[i] = (unsigned)(Rb * K + C) * 2u; }
    const size_t kstep = (size_t)(BK * 2);
    const size_t hstep = (size_t)HALF * K * 2;
    const size_t tstep = 2 * hstep;
    const unsigned ldsw = (unsigned)wid * 1024u;
    const int aoff = lds_byte(wr * 64 + fr, fq * 8), boff = lds_byte(wc * 32 + fr, fq * 8);
#define PG8_SA(b, h) (((b) * 2 + (h)) * HTB)
#define PG8_SB(b, h) ((4 + (b) * 2 + (h)) * HTB)
#define PG8_STAGE(bufoff, gbase, voff) do { _Pragma("unroll") for (int _i = 0; _i < 2; ++_i) \
        __builtin_amdgcn_global_load_lds((const unsigned*)((const char*)(gbase) + (voff)[_i]), (PG8_LAS unsigned*)(lds + (bufoff) + ldsw + _i * 8192), 16, 0, 0); } while (0)
#define PG8_LDA(dst, b, h) do { _Pragma("unroll") for (int m = 0; m < 4; ++m) _Pragma("unroll") for (int k = 0; k < 2; ++k) dst[m][k] = *(const PG8_LAS bf16x8*)(lds + PG8_SA(b, h) + aoff + m * 2048 + k * 1024); } while (0)
#define PG8_LDB(dst, b, h) do { _Pragma("unroll") for (int n = 0; n < 2; ++n) _Pragma("unroll") for (int k = 0; k < 2; ++k) dst[n][k] = *(const PG8_LAS bf16x8*)(lds + PG8_SB(b, h) + boff + n * 2048 + k * 1024); } while (0)
#define PG8_MMA(ai, bj, At, Bt) do { __builtin_amdgcn_s_setprio(1); _Pragma("unroll") for (int m = 0; m < 4; ++m) _Pragma("unroll") for (int n = 0; n < 2; ++n) _Pragma("unroll") for (int k = 0; k < 2; ++k) \
        acc[ai][bj][m][n] = __builtin_amdgcn_mfma_f32_16x16x32_bf16(Bt[n][k], At[m][k], acc[ai][bj][m][n], 0, 0, 0); __builtin_amdgcn_s_setprio(0); } while (0)
#define PG8_WAIT_V(n) asm volatile("s_waitcnt vmcnt(" #n ")" ::: "memory")
#define PG8_WAIT_L(n) asm volatile("s_waitcnt lgkmcnt(" #n ")" ::: "memory")
#define PG8_BAR __builtin_amdgcn_s_barrier()
#define PG8_SCHED __builtin_amdgcn_sched_barrier(0)
    Unit cur, nxt; int ui = 0;
    if (!S.next(0, cur)) return;
    f32x4 acc[2][2][4][2];
#pragma unroll
    for (int a = 0; a < 2; ++a)
#pragma unroll
        for (int b = 0; b < 2; ++b)
#pragma unroll
            for (int m = 0; m < 4; ++m)
#pragma unroll
                for (int n = 0; n < 2; ++n) acc[a][b][m][n] = (f32x4){0.f, 0.f, 0.f, 0.f};
    bf16x8 At[4][2], B0[2][2], B1[2][2];
    const char* cA = (const char*)g.A + (size_t)cur.pm * tstep; const char* cB = (const char*)g.Bt + (size_t)cur.pn * tstep;
    S.a_ready(cur);
    PG8_STAGE(PG8_SB(0, 0), cB, voffB); PG8_STAGE(PG8_SA(0, 0), cA, voffA); PG8_STAGE(PG8_SB(0, 1), cB + hstep, voffB); PG8_STAGE(PG8_SA(0, 1), cA + hstep, voffA);
    if (wr == 1) PG8_BAR;
    PG8_WAIT_V(4); PG8_BAR;
    PG8_STAGE(PG8_SB(1, 0), cB + kstep, voffB); PG8_STAGE(PG8_SA(1, 0), cA + kstep, voffA); PG8_STAGE(PG8_SB(1, 1), cB + hstep + kstep, voffB);
    PG8_WAIT_V(6); PG8_BAR;
    PG8_STAMP();
    for (;;) {
        const bool has_next = S.next(ui + 1, nxt);
        const char* nA = has_next ? (const char*)g.A + (size_t)nxt.pm * tstep : cA; const char* nB = has_next ? (const char*)g.Bt + (size_t)nxt.pn * tstep : cB;
        for (int t = 0; t < nt; t += 2) {
            const bool last = (t == nt - 2);
            const char* a1 = cA + (size_t)(t + 1) * kstep;
            const char* a2 = last ? nA : cA + (size_t)(t + 2) * kstep; const char* b2 = last ? nB : cB + (size_t)(t + 2) * kstep;
            const char* a3 = a2 + kstep; const char* b3 = b2 + kstep;
            if (last && has_next) S.a_ready(nxt);
            PG8_LDB(B0, 0, 0); PG8_SCHED; PG8_LDA(At, 0, 0); PG8_STAGE(PG8_SA(1, 1), a1 + hstep, voffA);
            PG8_WAIT_L(8); PG8_BAR; PG8_WAIT_L(0); PG8_MMA(0, 0, At, B0); PG8_BAR; PG8_SCHED;
            PG8_LDB(B1, 0, 1); PG8_STAGE(PG8_SB(0, 0), b2, voffB);
            PG8_BAR; PG8_WAIT_L(0); PG8_MMA(0, 1, At, B1); PG8_BAR;
            PG8_LDA(At, 0, 1); PG8_STAGE(PG8_SA(0, 0), a2, voffA);
            PG8_BAR; PG8_WAIT_L(0); PG8_MMA(1, 0, At, B0); PG8_BAR; PG8_SCHED;
            PG8_STAGE(PG8_SB(0, 1), b2 + hstep, voffB);
            PG8_WAIT_V(6); PG8_BAR; PG8_MMA(1, 1, At, B1); PG8_BAR;
            PG8_LDB(B0, 1, 0); PG8_SCHED; PG8_LDA(At, 1, 0); PG8_STAGE(PG8_SA(0, 1), a2 + hstep, voffA);
            PG8_WAIT_L(8); PG8_BAR; PG8_WAIT_L(0); PG8_MMA(0, 0, At, B0); PG8_BAR; PG8_SCHED;
            PG8_LDB(B1, 1, 1); PG8_STAGE(PG8_SB(1, 0), b3, voffB);
            PG8_BAR; PG8_WAIT_L(0); PG8_MMA(0, 1, At, B1); PG8_BAR;
            PG8_LDA(At, 1, 1); PG8_STAGE(PG8_SA(1, 0), a3, voffA);
            PG8_BAR; PG8_WAIT_L(0); PG8_MMA(1, 0, At, B0); PG8_BAR; PG8_SCHED;
            PG8_STAGE(PG8_SB(1, 1), b3 + hstep, voffB);
            PG8_WAIT_V(6); PG8_BAR; PG8_MMA(1, 1, At, B1); PG8_BAR;
        }
        PG8_STAMP();
        if constexpr (!Epi::AFTER_DRAIN) { E(acc, cur, wr, wc, fr, fq); S.done(cur); }
        PG8_STAMP();
        if (!has_next) break;
#pragma unroll
        for (int a = 0; a < 2; ++a)
#pragma unroll
            for (int b = 0; b < 2; ++b)
#pragma unroll
                for (int m = 0; m < 4; ++m)
#pragma unroll
                    for (int n = 0; n < 2; ++n) acc[a][b][m][n] = (f32x4){0.f, 0.f, 0.f, 0.f};
        cur = nxt; cA = nA; cB = nB; ++ui;
    }
    PG8_WAIT_V(0);
    if (wr == 0) PG8_BAR;
    PG8_BAR;
    if constexpr (Epi::AFTER_DRAIN) { E.fused(acc, cur, wr, wc, fr, fq, lds, wid, lane); S.done(cur); }
    PG8_STAMP();
    if (STAMP && wid == 0) { stamps[lane] = lane < nts ? (((unsigned long long)(unsigned)ts_hi << 32) | (unsigned)ts_lo) : 0ull;
        if (lane == 62) stamps[62] = rt_entry; if (lane == 63) stamps[63] = (unsigned long long)wall_clock64(); }
#undef PG8_STAMP
#undef PG8_SA
#undef PG8_SB
#undef PG8_STAGE
#undef PG8_LDA
#undef PG8_LDB
#undef PG8_MMA
#undef PG8_WAIT_V
#undef PG8_WAIT_L
#undef PG8_BAR
#undef PG8_SCHED
}
}


template <int N, int K, class Epi>
__device__ void small_gemm(unsigned char* lds, const bf16_t* __restrict__ A, const bf16_t* __restrict__ Bt, const Epi& epi) {
    constexpr int BN = N / 32, NTL = BN / 16, KS = (NTL == 2) ? 4 : 1, KW = K / KS, UN = 4;
    const int tid = otid(), lane = tid & 63, wid = tid >> 6, fr = lane & 15, g = lane >> 4;
    float* red = (float*)lds;
    for (int u = blockIdx.x; u < 256; u += gridDim.x) {
        const int mt = u & 7, ntile = u >> 3, nt = wid % NTL, ks = wid / NTL; const bool active = wid < NTL * KS;
        f32x4 acc[4];
#pragma unroll
        for (int m = 0; m < 4; ++m) acc[m] = (f32x4){0.f, 0.f, 0.f, 0.f};
        if (active) {
            const bf16_t* Ap = A + (size_t)(mt * 64 + fr) * K + ks * KW + g * 8;
            const bf16_t* Bp = Bt + (size_t)(ntile * BN + nt * 16 + fr) * K + ks * KW + g * 8;
#pragma unroll 1
            for (int k = 0; k < KW; k += 32 * UN) {
                bf16x8 a[UN][4], b[UN];
#pragma unroll
                for (int i = 0; i < UN; ++i) { b[i] = *(const bf16x8*)(Bp + k + i * 32);
#pragma unroll
                    for (int m = 0; m < 4; ++m) a[i][m] = *(const bf16x8*)(Ap + (size_t)m * 16 * K + k + i * 32); }
#pragma unroll
                for (int i = 0; i < UN; ++i)
#pragma unroll
                    for (int m = 0; m < 4; ++m) acc[m] = mfma16(b[i], a[i][m], acc[m]);
            }
        }
        if (KS > 1) {
            __syncthreads();
#pragma unroll
            for (int m = 0; m < 4; ++m) *(f32x4*)(red + ((ks * 64 + m * 16 + fr) * BN + nt * 16 + g * 4)) = acc[m];
            __syncthreads();
            const int row = tid >> 3, c4 = (tid & 7) * 4;
            f32x4 s = *(const f32x4*)(red + (row * BN + c4));
#pragma unroll
            for (int q = 1; q < KS; ++q) s += *(const f32x4*)(red + ((q * 64 + row) * BN + c4));
            epi(TP + mt * 64 + row, ntile * BN + c4, s);
        } else if (active) {
#pragma unroll
            for (int m = 0; m < 4; ++m) epi(TP + mt * 64 + m * 16 + fr, ntile * BN + nt * 16 + g * 4, acc[m]);
        }
    }
}
__device__ void ln_phase(float* X, bf16_t* Xb, const float* __restrict__ gam, const float* __restrict__ bet) {
    const int tid = otid(), lane = tid & 63, wid = tid >> 6;
    for (int row = blockIdx.x * 8 + wid; row < TT; row += gridDim.x * 8) {
        f32x4 v[4]; float s = 0.f;
#pragma unroll
        for (int i = 0; i < 4; ++i) { v[i] = *(const f32x4*)(X + (size_t)row * DM + i * 256 + lane * 4); s += (v[i][0] + v[i][1]) + (v[i][2] + v[i][3]); }
#pragma unroll
        for (int o = 1; o < 64; o <<= 1) s += __shfl_xor(s, o);
        const float mu = s * (1.0f / 1024.0f); float q = 0.f;
#pragma unroll
        for (int i = 0; i < 4; ++i) { const f32x4 d = v[i] - mu; q += (d[0] * d[0] + d[1] * d[1]) + (d[2] * d[2] + d[3] * d[3]); }
#pragma unroll
        for (int o = 1; o < 64; o <<= 1) q += __shfl_xor(q, o);
        const float rstd = rsqrtf(q * (1.0f / 1024.0f) + 1e-5f);
#pragma unroll
        for (int i = 0; i < 4; ++i) { const int c = i * 256 + lane * 4; const f32x4 gg = *(const f32x4*)(gam + c), bb = *(const f32x4*)(bet + c);
            const f32x4 o = (v[i] - mu) * rstd * gg + bb; *(f32x4*)(X + (size_t)row * DM + c) = o;
            u32x2 w; w.x = pk2(o[0], o[1]); w.y = pk2(o[2], o[3]); *(u32x2*)(Xb + (size_t)row * DM + c) = w; }
    }
}

constexpr int QS = 72, BS = 68, VS = 136;
template <int DK, bool WITH_Q>
__device__ void stage_chunk(unsigned char* lds, const Params& p, int l, int n, int h, int c) {
    constexpr bool HG = (DK == 64);
    bf16_t* sQ = (bf16_t*)lds; bf16_t* sK = (bf16_t*)(lds + 18432); float* sB = (float*)(lds + 36864); bf16_t* sVt = (bf16_t*)(lds + 71680); float* sTot = (float*)(lds + 106496);
    const bf16_t* H = (const bf16_t*)(p.ws + WS_R1);
    const int tid = otid(); const int row0 = n * SEQ + c * 128;
    if (HG) {
#pragma unroll
        for (int i = 0; i < 2; ++i) { const int idx = tid + i * 512, t = idx >> 3, dg = idx & 7; const bf16_t* hr = H + (size_t)(row0 + t) * NIN;
            float hf[8], kk[8]; unpack8(*(const u32x4*)(hr + C_HF + h * 64 + dg * 8), hf);
#pragma unroll
            for (int j = 0; j < 8; ++j) { const float lb = lb_val(p.lb_raw, l, h * 64 + dg * 8 + j); const float k = (1.0f - lb) / (1.0f + expf(hf[j])); kk[j] = k; sB[t * BS + dg * 8 + j] = log1pf(-k); }
            *(u32x4*)(sK + t * QS + dg * 8) = pack8(kk);
            if (WITH_Q) *(u32x4*)(sQ + t * QS + dg * 8) = *(const u32x4*)(hr + C_HQ + h * 64 + dg * 8);
            float vv[8]; unpack8(*(const u32x4*)(hr + C_HI + h * 64 + dg * 8), vv);
#pragma unroll
            for (int j = 0; j < 8; ++j) sVt[(dg * 8 + j) * VS + t] = f2bf(vv[j]);
        }
        __syncthreads();
        { const int d = tid & 63, seg = tid >> 6; float a = 0.f;
#pragma unroll
          for (int j = 0; j < 16; ++j) { a += sB[(seg * 16 + j) * BS + d]; sB[(seg * 16 + j) * BS + d] = a; }
          sTot[seg * 64 + d] = a;
          __syncthreads();
          float off = 0.f;
          for (int s2 = 0; s2 < seg; ++s2) off += sTot[s2 * 64 + d];
          if (seg > 0) {
#pragma unroll
              for (int j = 0; j < 16; ++j) sB[(seg * 16 + j) * BS + d] += off; }
        }
    } else {
        const float lg = ret_lg(h);
        if (tid < 256) { const int t = tid >> 1, ig = tid & 1; const bf16_t* hr = H + (size_t)(row0 + t) * NIN; const float pos = (float)(c * 128 + t);
            float k1[8], k2[8], o1[8], o2[8], cs[8], sn[8];
#pragma unroll
            for (int j = 0; j < 8; ++j) sincos_red(pos * ret_inv(ig * 8 + j), sn[j], cs[j]);
            unpack8(*(const u32x4*)(hr + C_RK + h * 32 + ig * 8), k1); unpack8(*(const u32x4*)(hr + C_RK + h * 32 + 16 + ig * 8), k2);
#pragma unroll
            for (int j = 0; j < 8; ++j) { o1[j] = (k1[j] * cs[j] - k2[j] * sn[j]) * 0.17677669529663687f; o2[j] = (k2[j] * cs[j] + k1[j] * sn[j]) * 0.17677669529663687f; }
            *(u32x4*)(sK + t * QS + ig * 8) = pack8(o1); *(u32x4*)(sK + t * QS + 16 + ig * 8) = pack8(o2);
            if (WITH_Q) {
                unpack8(*(const u32x4*)(hr + C_RQ + h * 32 + ig * 8), k1); unpack8(*(const u32x4*)(hr + C_RQ + h * 32 + 16 + ig * 8), k2);
#pragma unroll
                for (int j = 0; j < 8; ++j) { o1[j] = k1[j] * cs[j] - k2[j] * sn[j]; o2[j] = k2[j] * cs[j] + k1[j] * sn[j]; }
                *(u32x4*)(sQ + t * QS + ig * 8) = pack8(o1); *(u32x4*)(sQ + t * QS + 16 + ig * 8) = pack8(o2);
            }
        }
#pragma unroll
        for (int i = 0; i < 8; ++i) { const int idx = tid + i * 512, t = idx >> 5, d = idx & 31; sB[t * BS + d] = (float)(t + 1) * lg; }
#pragma unroll
        for (int i = 0; i < 2; ++i) { const int idx = tid + i * 512, t = idx >> 3, dg = idx & 7; const bf16_t* hr = H + (size_t)(row0 + t) * NIN;
            float vv[8]; unpack8(*(const u32x4*)(hr + C_RV + h * 64 + dg * 8), vv);
#pragma unroll
            for (int j = 0; j < 8; ++j) sVt[(dg * 8 + j) * VS + t] = f2bf(vv[j]);
        }
    }
    __syncthreads();
}

template <int DK>
__device__ void local_state_item(unsigned char* lds, const Params& p, int l, int n, int h, int c) {
    constexpr bool HG = (DK == 64);
    bf16_t* sK = (bf16_t*)(lds + 18432); float* sB = (float*)(lds + 36864); bf16_t* sVt = (bf16_t*)(lds + 71680); bf16_t* sKt = (bf16_t*)(lds + 89088);
    const int tid = otid(), lane = tid & 63, wid = tid >> 6, fr = lane & 15, g = lane >> 4;
    __syncthreads();
    stage_chunk<DK, false>(lds, p, l, n, h, c);
    for (int idx = tid; idx < 128 * DK / 8; idx += 512) { const int t = idx / (DK / 8), dg = idx % (DK / 8);
        float kk[8]; unpack8(*(const u32x4*)(sK + t * QS + dg * 8), kk);
#pragma unroll
        for (int j = 0; j < 8; ++j) { const int d = dg * 8 + j; sKt[d * VS + t] = f2bf(kk[j] * expf(sB[127 * BS + d] - sB[t * BS + d])); }
    }
    const int ci = (n * 4 + h) * 64 + c;
    if (HG && tid < 64) ((float*)(p.ws + WS_DEC))[ci * 64 + tid] = expf(sB[127 * BS + tid]);
    __syncthreads();
    float* Sl = (float*)(p.ws + (HG ? WS_SLH : WS_SLR)) + (size_t)ci * DK * 64;
    constexpr int NTILE = HG ? 2 : 1;
#pragma unroll
    for (int tt = 0; tt < NTILE; ++tt) {
        const int dt = HG ? (wid >> 1) : (wid >> 2), vt = HG ? ((wid & 1) * 2 + tt) : (wid & 3);
        f32x4 acc = (f32x4){0.f, 0.f, 0.f, 0.f};
#pragma unroll
        for (int ks = 0; ks < 4; ++ks) {
            const bf16x8 a = *(const bf16x8*)(sKt + (dt * 16 + fr) * VS + ks * 32 + g * 8);
            const bf16x8 b = *(const bf16x8*)(sVt + (vt * 16 + fr) * VS + ks * 32 + g * 8);
            acc = mfma16(a, b, acc);
        }
#pragma unroll
        for (int j = 0; j < 4; ++j) Sl[(dt * 16 + g * 4 + j) * 64 + vt * 16 + fr] = acc[j];
    }
}

__device__ void scan_phase(const Params& p, int l) {
    const int gt = blockIdx.x * NT + otid();
    if (gt < 32768 + 16384) {
        const bool hg = gt < 32768; const int g2 = hg ? gt : gt - 32768;
        const int esz = hg ? 4096 : 2048, ch = hg ? (g2 >> 12) : (g2 >> 11), e = g2 & (esz - 1);
        const float* Sl = (const float*)(p.ws + (hg ? WS_SLH : WS_SLR)) + (size_t)ch * 64 * esz + e;
        float* Si = (float*)(p.ws + (hg ? WS_SIH : WS_SIR)) + (size_t)ch * 64 * esz + e;
        const float* dec = (const float*)(p.ws + WS_DEC) + (size_t)ch * 64 * 64 + (e >> 6);
        const float dc = expf(128.0f * ret_lg(ch & 3));
        float S = 0.f;
#pragma unroll 1
        for (int c0 = 0; c0 < 64; c0 += 8) { float sl[8], dd[8];
#pragma unroll
            for (int j = 0; j < 8; ++j) { sl[j] = Sl[(size_t)j * esz]; dd[j] = hg ? dec[j * 64] : dc; }
#pragma unroll
            for (int j = 0; j < 8; ++j) { Si[(size_t)j * esz] = S; S = dd[j] * S + sl[j]; }
            Sl += (size_t)8 * esz; Si += (size_t)8 * esz; dec += 8 * 64; }
        p.out[(hg ? O_PH : O_PR) + (size_t)(l * 8 + ch) * esz + e] = S;
    }
}

template <int DK>
__device__ void chunk_out_item(unsigned char* lds, const Params& p, int l, int n, int h, int c) {
    constexpr bool HG = (DK == 64); constexpr int NKS = DK / 32;
    bf16_t* sQ = (bf16_t*)lds; bf16_t* sK = (bf16_t*)(lds + 18432); float* sB = (float*)(lds + 36864); bf16_t* sVt = (bf16_t*)(lds + 71680); bf16_t* sS0 = (bf16_t*)(lds + 89088);
    const bf16_t* H = (const bf16_t*)(p.ws + WS_R1); bf16_t* CAT = (bf16_t*)(p.ws + WS_CAT);
    const int tid = otid(), lane = tid & 63, wid = tid >> 6, fr = lane & 15, g = lane >> 4;
    __syncthreads();
    const int ci = (n * 4 + h) * 64 + c;
    { const float* Si = (const float*)(p.ws + (HG ? WS_SIH : WS_SIR)) + (size_t)ci * DK * 64;
      for (int idx = tid; idx < DK * 64; idx += 512) { const int d = idx >> 6, v = idx & 63; sS0[v * QS + d] = f2bf(Si[idx]); } }
    stage_chunk<DK, true>(lds, p, l, n, h, c);
    const int i = wid, t = 16 * i + fr;
    bf16x8 qt[NKS], qh[NKS]; float r[NKS][8];
#pragma unroll
    for (int ks = 0; ks < NKS; ++ks) { float q[8], a[8], b2[8]; unpack8(*(const u32x4*)(sQ + t * QS + ks * 32 + g * 8), q);
#pragma unroll
        for (int e = 0; e < 8; ++e) { const int d = ks * 32 + g * 8 + e; const float bt = sB[t * BS + d]; r[ks][e] = (i == 0) ? 0.f : sB[(16 * i - 1) * BS + d]; a[e] = q[e] * expf(bt - r[ks][e]); b2[e] = q[e] * expf(bt); }
        qt[ks] = as_bf8(pack8(a)); qh[ks] = as_bf8(pack8(b2)); }
    f32x4 acc[4];
#pragma unroll
    for (int vt = 0; vt < 4; ++vt) { acc[vt] = (f32x4){0.f, 0.f, 0.f, 0.f};
#pragma unroll
        for (int ks = 0; ks < NKS; ++ks) acc[vt] = mfma16(*(const bf16x8*)(sS0 + (vt * 16 + fr) * QS + ks * 32 + g * 8), qh[ks], acc[vt]); }
    for (int jp = 0; jp <= i; jp += 2) {
        f32x4 aT[2];
#pragma unroll
        for (int jj = 0; jj < 2; ++jj) { const int j = jp + jj; aT[jj] = (f32x4){0.f, 0.f, 0.f, 0.f};
            if (j <= i) { const int s = 16 * j + fr;
#pragma unroll
                for (int ks = 0; ks < NKS; ++ks) { float kk[8]; unpack8(*(const u32x4*)(sK + s * QS + ks * 32 + g * 8), kk);
#pragma unroll
                    for (int e = 0; e < 8; ++e) kk[e] *= expf(r[ks][e] - sB[s * BS + ks * 32 + g * 8 + e]);
                    aT[jj] = mfma16(as_bf8(pack8(kk)), qt[ks], aT[jj]); }
                if (j == i) {
#pragma unroll
                    for (int e = 0; e < 4; ++e) if (g * 4 + e > fr) aT[jj][e] = 0.f; }
            } }
        u32x4 pb; pb.x = pk2(aT[0][0], aT[0][1]); pb.y = pk2(aT[0][2], aT[0][3]); pb.z = pk2(aT[1][0], aT[1][1]); pb.w = pk2(aT[1][2], aT[1][3]);
        const int j1 = (jp + 1 <= i) ? jp + 1 : jp;
#pragma unroll
        for (int vt = 0; vt < 4; ++vt) { u32x4 av; const u32x2 a0 = *(const u32x2*)(sVt + (vt * 16 + fr) * VS + 16 * jp + g * 4), a1 = *(const u32x2*)(sVt + (vt * 16 + fr) * VS + 16 * j1 + g * 4);
            av.x = a0.x; av.y = a0.y; av.z = a1.x; av.w = a1.y; acc[vt] = mfma16(as_bf8(av), as_bf8(pb), acc[vt]); }
    }
    float ss = 0.f;
#pragma unroll
    for (int vt = 0; vt < 4; ++vt) ss += (acc[vt][0] * acc[vt][0] + acc[vt][1] * acc[vt][1]) + (acc[vt][2] * acc[vt][2] + acc[vt][3] * acc[vt][3]);
    ss += __shfl_xor(ss, 16); ss += __shfl_xor(ss, 32);
    const float rms = rsqrtf(ss * (1.0f / 64.0f) + 1e-6f);
    const int row = n * SEQ + c * 128 + t;
#pragma unroll
    for (int vt = 0; vt < 4; ++vt) { const int v0 = vt * 16 + g * 4; const u32x2 gu = *(const u32x2*)(H + (size_t)row * NIN + (HG ? C_HG : C_RG) + h * 64 + v0);
        const float g0 = bflo(gu.x), g1 = bfhi(gu.x), g2 = bflo(gu.y), g3 = bfhi(gu.y); float w0 = rms, w1 = rms, w2 = rms, w3 = rms;
        if (HG) { const f32x4 nw = *(const f32x4*)(p.hg_norm_w + l * 64 + v0); w0 *= nw[0]; w1 *= nw[1]; w2 *= nw[2]; w3 *= nw[3]; }
        u32x2 o; o.x = pk2(acc[vt][0] * w0 * silu(g0), acc[vt][1] * w1 * silu(g1)); o.y = pk2(acc[vt][2] * w2 * silu(g2), acc[vt][3] * w3 * silu(g3));
        *(u32x2*)(CAT + (size_t)row * DM + (HG ? 256 : 0) + h * 64 + v0) = o; }
}

__device__ void swa_prompt_item(unsigned char* lds, const Params& p, int l, int n, int qb, int kvh) {
    constexpr int VT = 200;
    bf16_t* sK = (bf16_t*)lds; bf16_t* sVt = (bf16_t*)(lds + 27648); bf16_t* sQ = (bf16_t*)(lds + 53248);
    const bf16_t* H = (const bf16_t*)(p.ws + WS_R1); bf16_t* CAT = (bf16_t*)(p.ws + WS_CAT);
    const int tid = otid(), lane = tid & 63, wid = tid >> 6, fr = lane & 15, g = lane >> 4;
    const int q0 = qb * 64;
    __syncthreads();
#pragma unroll
    for (int it = 0; it < 3; ++it) { const int idx = tid + it * 512, key = idx >> 3, dg = idx & 7; const int pos = q0 - 128 + key;
        const bool ok = pos >= 0; const bf16_t* hr = H + (size_t)(n * SEQ + (ok ? pos : 0)) * NIN;
        const bool wr_cache = (qb >= 126) && (key >= 128);
        float* ok_out = p.out + O_PK + ((size_t)((l * 2 + n) * 128 + (pos - (SEQ - 128))) * 2 + kvh) * 64;
        float* ov_out = p.out + O_PV + ((size_t)((l * 2 + n) * 128 + (pos - (SEQ - 128))) * 2 + kvh) * 64;
        if (dg == 0) { float x1[8], x2[8], o1[8], o2[8];
            unpack8(*(const u32x4*)(hr + C_SK + kvh * 64), x1); unpack8(*(const u32x4*)(hr + C_SK + kvh * 64 + 8), x2);
#pragma unroll
            for (int j = 0; j < 8; ++j) { float sn, cs; sincos_red((float)pos * swa_inv(j), sn, cs); o1[j] = ok ? (x1[j] * cs - x2[j] * sn) : 0.f; o2[j] = ok ? (x2[j] * cs + x1[j] * sn) : 0.f; }
            *(u32x4*)(sK + key * QS) = pack8(o1); *(u32x4*)(sK + key * QS + 8) = pack8(o2);
            if (wr_cache) {
#pragma unroll
                for (int j = 0; j < 8; ++j) { ok_out[j] = bf2f(f2bf(o1[j])); ok_out[8 + j] = bf2f(f2bf(o2[j])); } }
        } else if (dg >= 2) { u32x4 kv = *(const u32x4*)(hr + C_SK + kvh * 64 + dg * 8); if (!ok) kv = (u32x4){0u, 0u, 0u, 0u}; *(u32x4*)(sK + key * QS + dg * 8) = kv;
            if (wr_cache) { float kk[8]; unpack8(kv, kk);
#pragma unroll
                for (int j = 0; j < 8; ++j) ok_out[dg * 8 + j] = kk[j]; } }
        { float vv[8]; unpack8(*(const u32x4*)(hr + C_SV + kvh * 64 + dg * 8), vv);
#pragma unroll
          for (int j = 0; j < 8; ++j) { sVt[(dg * 8 + j) * VT + key] = ok ? f2bf(vv[j]) : (bf16_t)0; if (wr_cache) ov_out[dg * 8 + j] = vv[j]; } }
    }
#pragma unroll
    for (int it = 0; it < 4; ++it) { const int idx = tid + it * 512, rw = idx >> 3, dg = idx & 7, hh = rw >> 6, iq = rw & 63; const int pos = q0 + iq;
        const bf16_t* hr = H + (size_t)(n * SEQ + pos) * NIN + C_SQ + (kvh * 4 + hh) * 64;
        if (dg == 0) { float x1[8], x2[8], o1[8], o2[8]; unpack8(*(const u32x4*)(hr), x1); unpack8(*(const u32x4*)(hr + 8), x2);
#pragma unroll
            for (int j = 0; j < 8; ++j) { float sn, cs; sincos_red((float)pos * swa_inv(j), sn, cs); o1[j] = (x1[j] * cs - x2[j] * sn) * 0.125f; o2[j] = (x2[j] * cs + x1[j] * sn) * 0.125f; }
            *(u32x4*)(sQ + rw * QS) = pack8(o1); *(u32x4*)(sQ + rw * QS + 8) = pack8(o2);
        } else if (dg >= 2) { float x[8]; unpack8(*(const u32x4*)(hr + dg * 8), x);
#pragma unroll
            for (int j = 0; j < 8; ++j) x[j] *= 0.125f;
            *(u32x4*)(sQ + rw * QS + dg * 8) = pack8(x); }
    }
    __syncthreads();
    const int hh = wid >> 1, qh = wid & 1; const float sink = p.sinks[l * 8 + kvh * 4 + hh];
    bf16x8 bq[2][2];
#pragma unroll
    for (int qt = 0; qt < 2; ++qt)
#pragma unroll
        for (int ks = 0; ks < 2; ++ks) bq[qt][ks] = *(const bf16x8*)(sQ + (hh * 64 + 32 * qh + 16 * qt + fr) * QS + ks * 32 + g * 8);
    f32x4 sT[10][2];
#pragma unroll
    for (int kt = 0; kt < 10; ++kt) { const int krow = 16 * (2 * qh + kt) + fr;
        const bf16x8 a0 = *(const bf16x8*)(sK + krow * QS + g * 8), a1 = *(const bf16x8*)(sK + krow * QS + 32 + g * 8);
#pragma unroll
        for (int qt = 0; qt < 2; ++qt) { f32x4 z = (f32x4){0.f, 0.f, 0.f, 0.f}; z = mfma16(a0, bq[qt][0], z); z = mfma16(a1, bq[qt][1], z); sT[kt][qt] = z; } }
    float mx[2] = {-INFINITY, -INFINITY};
#pragma unroll
    for (int kt = 0; kt < 10; ++kt)
#pragma unroll
        for (int qt = 0; qt < 2; ++qt)
#pragma unroll
            for (int e = 0; e < 4; ++e) { const int j = 16 * (2 * qh + kt) + g * 4 + e, iq = 32 * qh + 16 * qt + fr; const bool valid = (j >= iq) && (j <= iq + 128) && (q0 - 128 + j >= 0);
                const float s = valid ? sT[kt][qt][e] : -INFINITY; sT[kt][qt][e] = s; mx[qt] = fmaxf(mx[qt], s); }
    float den[2];
#pragma unroll
    for (int qt = 0; qt < 2; ++qt) { float m = mx[qt]; m = fmaxf(m, __shfl_xor(m, 16)); m = fmaxf(m, __shfl_xor(m, 32)); m = fmaxf(m, sink); mx[qt] = m; den[qt] = 0.f; }
#pragma unroll
    for (int kt = 0; kt < 10; ++kt)
#pragma unroll
        for (int qt = 0; qt < 2; ++qt)
#pragma unroll
            for (int e = 0; e < 4; ++e) { const float pe = expf(sT[kt][qt][e] - mx[qt]); sT[kt][qt][e] = pe; den[qt] += pe; }
#pragma unroll
    for (int qt = 0; qt < 2; ++qt) { float d = den[qt]; d += __shfl_xor(d, 16); d += __shfl_xor(d, 32); den[qt] = 1.0f / (d + expf(sink - mx[qt])); }
    f32x4 oT[4][2];
#pragma unroll
    for (int dt = 0; dt < 4; ++dt)
#pragma unroll
        for (int qt = 0; qt < 2; ++qt) oT[dt][qt] = (f32x4){0.f, 0.f, 0.f, 0.f};
#pragma unroll
    for (int kp = 0; kp < 5; ++kp) {
        u32x4 pb[2];
#pragma unroll
        for (int qt = 0; qt < 2; ++qt) { pb[qt].x = pk2(sT[2 * kp][qt][0], sT[2 * kp][qt][1]); pb[qt].y = pk2(sT[2 * kp][qt][2], sT[2 * kp][qt][3]); pb[qt].z = pk2(sT[2 * kp + 1][qt][0], sT[2 * kp + 1][qt][1]); pb[qt].w = pk2(sT[2 * kp + 1][qt][2], sT[2 * kp + 1][qt][3]); }
        const int kb = 16 * (2 * qh + 2 * kp);
#pragma unroll
        for (int dt = 0; dt < 4; ++dt) { const u32x2 a0 = *(const u32x2*)(sVt + (dt * 16 + fr) * VT + kb + g * 4), a1 = *(const u32x2*)(sVt + (dt * 16 + fr) * VT + kb + 16 + g * 4);
            u32x4 av; av.x = a0.x; av.y = a0.y; av.z = a1.x; av.w = a1.y;
#pragma unroll
            for (int qt = 0; qt < 2; ++qt) oT[dt][qt] = mfma16(as_bf8(av), as_bf8(pb[qt]), oT[dt][qt]); }
    }
#pragma unroll
    for (int qt = 0; qt < 2; ++qt) { const int row = n * SEQ + q0 + 32 * qh + 16 * qt + fr;
#pragma unroll
        for (int dt = 0; dt < 4; ++dt) { u32x2 o; o.x = pk2(oT[dt][qt][0] * den[qt], oT[dt][qt][1] * den[qt]); o.y = pk2(oT[dt][qt][2] * den[qt], oT[dt][qt][3] * den[qt]);
            *(u32x2*)(CAT + (size_t)row * DM + 512 + (kvh * 4 + hh) * 64 + dt * 16 + g * 4) = o; } }
}

template <int DK>
__device__ void sample_rec_item(unsigned char* lds, const Params& p, int l, int n, int h) {
    constexpr bool HG = (DK == 64); constexpr int PER = DK / 8;
    float* sq = (float*)lds; float* sk = sq + 256; float* sf = sk + 256; float* sv = sf + 256; float* spart = sv + 256;
    const bf16_t* H = (const bf16_t*)(p.ws + WS_R1); bf16_t* CAT = (bf16_t*)(p.ws + WS_CAT);
    const int tid = otid(), lane = tid & 63, wid = tid >> 6; const int row0 = TP + n * 4;
    __syncthreads();
    if (HG) {
        if (tid < 256) { const int t = tid >> 6, d = tid & 63; const bf16_t* hr = H + (size_t)(row0 + t) * NIN;
            const float hf = bf2f(hr[C_HF + h * 64 + d]); const float lb = lb_val(p.lb_raw, l, h * 64 + d); const float k = (1.0f - lb) / (1.0f + expf(hf));
            sk[t * 64 + d] = k; sf[t * 64 + d] = 1.0f - k; sq[t * 64 + d] = bf2f(hr[C_HQ + h * 64 + d]); }
        else { const int t = (tid - 256) >> 6, v = tid & 63; sv[t * 64 + v] = bf2f(H[(size_t)(row0 + t) * NIN + C_HI + h * 64 + v]); }
    } else {
        const float gam = 1.0f - exp2f(-5.0f - (float)h);
        if (tid < 64) { const int t = tid >> 4, i = tid & 15; const bf16_t* hr = H + (size_t)(row0 + t) * NIN; float sn, cs; sincos_red((float)(SEQ + t) * ret_inv(i), sn, cs);
            const float q1 = bf2f(hr[C_RQ + h * 32 + i]), q2 = bf2f(hr[C_RQ + h * 32 + 16 + i]), k1 = bf2f(hr[C_RK + h * 32 + i]), k2 = bf2f(hr[C_RK + h * 32 + 16 + i]);
            sq[t * 64 + i] = q1 * cs - q2 * sn; sq[t * 64 + 16 + i] = q2 * cs + q1 * sn;
            sk[t * 64 + i] = (k1 * cs - k2 * sn) * 0.17677669529663687f; sk[t * 64 + 16 + i] = (k2 * cs + k1 * sn) * 0.17677669529663687f;
            sf[t * 64 + i] = gam; sf[t * 64 + 16 + i] = gam; }
        if (tid >= 256) { const int t = (tid - 256) >> 6, v = tid & 63; sv[t * 64 + v] = bf2f(H[(size_t)(row0 + t) * NIN + C_RV + h * 64 + v]); }
    }
    __syncthreads();
    const int v = lane, dg = wid; float S[PER];
    const float* Sin = (HG ? p.state_hgrn : p.state_ret) + ((size_t)((l * 128 + n) * 4 + h) * DK) * 64;
    float* Sout = p.out + (HG ? O_SH : O_SR) + ((size_t)((l * 128 + n) * 4 + h) * DK) * 64;
#pragma unroll
    for (int i = 0; i < PER; ++i) S[i] = Sin[(dg * PER + i) * 64 + v];
#pragma unroll
    for (int t = 0; t < 4; ++t) { float part = 0.f; const float vv = sv[t * 64 + v];
#pragma unroll
        for (int i = 0; i < PER; ++i) { const int d = dg * PER + i; S[i] = sf[t * 64 + d] * S[i] + sk[t * 64 + d] * vv; part += sq[t * 64 + d] * S[i]; }
        spart[(t * 8 + dg) * 64 + v] = part; }
#pragma unroll
    for (int i = 0; i < PER; ++i) Sout[(dg * PER + i) * 64 + v] = S[i];
    __syncthreads();
    if (tid < 256) { const int t = wid; float o = 0.f;
#pragma unroll
        for (int k = 0; k < 8; ++k) o += spart[(t * 8 + k) * 64 + v];
        float ss = o * o;
#pragma unroll
        for (int m = 1; m < 64; m <<= 1) ss += __shfl_xor(ss, m);
        const float rms = rsqrtf(ss * (1.0f / 64.0f) + 1e-6f);
        const float gt = bf2f(H[(size_t)(row0 + t) * NIN + (HG ? C_HG : C_RG) + h * 64 + v]);
        float w = rms; if (HG) w *= p.hg_norm_w[l * 64 + v];
        CAT[(size_t)(row0 + t) * DM + (HG ? 256 : 0) + h * 64 + v] = f2bf(o * w * silu(gt)); }
}

__device__ void swa_sample_item(unsigned char* lds, const Params& p, int l, int n, int kvh) {
    float* sKa = (float*)lds; float* sVa = (float*)(lds + 34320); float* sQq = (float*)(lds + 68112); float* sP = (float*)(lds + 72208);
    const bf16_t* H = (const bf16_t*)(p.ws + WS_R1); bf16_t* CAT = (bf16_t*)(p.ws + WS_CAT);
    const int tid = otid(), lane = tid & 63, wid = tid >> 6; const int row0 = TP + n * 4;
    __syncthreads();
    const size_t cbase = (size_t)(l * 128 + n) * 128 * 128;
    for (int idx = tid; idx < 128 * 64; idx += 512) { const int j = idx >> 6, d = idx & 63; sKa[j * 65 + d] = p.cache_k[cbase + (size_t)(j * 2 + kvh) * 64 + d]; sVa[j * 64 + d] = p.cache_v[cbase + (size_t)(j * 2 + kvh) * 64 + d]; }
    if (tid < 256) { const int t = tid >> 6, d = tid & 63; const bf16_t* hr = H + (size_t)(row0 + t) * NIN;
        sVa[(128 + t) * 64 + d] = bf2f(hr[C_SV + kvh * 64 + d]);
        if (d >= 16) sKa[(128 + t) * 65 + d] = bf2f(hr[C_SK + kvh * 64 + d]);
        else if (d < 8) { float sn, cs; sincos_red((float)(SEQ + t) * swa_inv(d), sn, cs); const float x1 = bf2f(hr[C_SK + kvh * 64 + d]), x2 = bf2f(hr[C_SK + kvh * 64 + 8 + d]);
            sKa[(128 + t) * 65 + d] = x1 * cs - x2 * sn; sKa[(128 + t) * 65 + 8 + d] = x2 * cs + x1 * sn; } }
    for (int idx = tid; idx < 16 * 64; idx += 512) { const int r = idx >> 6, d = idx & 63, t = r >> 2, hh = r & 3; const bf16_t* hr = H + (size_t)(row0 + t) * NIN + C_SQ + (kvh * 4 + hh) * 64;
        if (d >= 16) sQq[r * 64 + d] = bf2f(hr[d]);
        else if (d < 8) { float sn, cs; sincos_red((float)(SEQ + t) * swa_inv(d), sn, cs); const float x1 = bf2f(hr[d]), x2 = bf2f(hr[8 + d]); sQq[r * 64 + d] = x1 * cs - x2 * sn; sQq[r * 64 + 8 + d] = x2 * cs + x1 * sn; } }
    __syncthreads();
    for (int pi = tid; pi < 16 * 132; pi += 512) { const int r = pi / 132, j = pi % 132, t = r >> 2; float s = 0.f;
#pragma unroll 16
        for (int d = 0; d < 64; ++d) s += sQq[r * 64 + d] * sKa[j * 65 + d];
        sP[r * 136 + j] = (j >= t && j <= t + 128) ? s * 0.125f : -INFINITY; }
    __syncthreads();
#pragma unroll
    for (int rr = 0; rr < 2; ++rr) { const int r = wid * 2 + rr, hh = r & 3; const float sink = p.sinks[l * 8 + kvh * 4 + hh];
        const float s0 = sP[r * 136 + lane], s1 = sP[r * 136 + 64 + lane], s2 = (lane < 4) ? sP[r * 136 + 128 + lane] : -INFINITY;
        float m = fmaxf(fmaxf(s0, s1), s2);
#pragma unroll
        for (int o = 1; o < 64; o <<= 1) m = fmaxf(m, __shfl_xor(m, o));
        m = fmaxf(m, sink);
        const float p0 = expf(s0 - m), p1 = expf(s1 - m), p2 = expf(s2 - m); float dsum = p0 + p1 + p2;
#pragma unroll
        for (int o = 1; o < 64; o <<= 1) dsum += __shfl_xor(dsum, o);
        const float inv = 1.0f / (dsum + expf(sink - m));
        sP[r * 136 + lane] = p0 * inv; sP[r * 136 + 64 + lane] = p1 * inv; if (lane < 4) sP[r * 136 + 128 + lane] = p2 * inv; }
    __syncthreads();
#pragma unroll
    for (int rr = 0; rr < 2; ++rr) { const int r = wid + rr * 8, d = lane, t = r >> 2, hh = r & 3; float o = 0.f;
        for (int j = 0; j < 132; ++j) o += sP[r * 136 + j] * sVa[j * 64 + d];
        CAT[(size_t)(row0 + t) * DM + 512 + (kvh * 4 + hh) * 64 + d] = f2bf(o); }
    for (int idx = tid; idx < 128 * 64; idx += 512) { const int j = idx >> 6, d = idx & 63; const size_t o = cbase + (size_t)(j * 2 + kvh) * 64 + d;
        p.out[O_SK + o] = sKa[(j + 4) * 65 + d]; p.out[O_SV + o] = sVa[(j + 4) * 64 + d]; }
}

__device__ void mix_a_phase(unsigned char* lds, const Params& p, int l) {
    for (int it = blockIdx.x; it < 2816; it += gridDim.x) {
        if (it < 512) { swa_prompt_item(lds, p, l, it >> 8, (it >> 1) & 127, it & 1); }
        else if (it < 1536) { const int k = it - 512, ty = k >> 9, n = (k >> 8) & 1, h = (k >> 6) & 3, c = k & 63;
            if (ty == 0) local_state_item<64>(lds, p, l, n, h, c); else local_state_item<32>(lds, p, l, n, h, c); }
        else if (it < 2560) { const int k = it - 1536, ty = k >> 9, n = (k >> 2) & 127, h = k & 3;
            if (ty == 0) sample_rec_item<64>(lds, p, l, n, h); else sample_rec_item<32>(lds, p, l, n, h); }
        else { const int k = it - 2560; swa_sample_item(lds, p, l, k >> 1, k & 1); }
    }
}
__device__ void mix_c_phase(unsigned char* lds, const Params& p, int l) {
    for (int it = blockIdx.x; it < 1024; it += gridDim.x) { const int ty = it >> 9, n = (it >> 8) & 1, h = (it >> 6) & 3, c = it & 63;
        if (ty == 0) chunk_out_item<64>(lds, p, l, n, h, c); else chunk_out_item<32>(lds, p, l, n, h, c); }
}

__global__ void __launch_bounds__(NT) fwd_megakernel(Params p) {
    extern __shared__ __attribute__((aligned(16))) unsigned char lds[];
    cg::grid_group grid = cg::this_grid();
    PG8_LAS unsigned char* L = (PG8_LAS unsigned char*)lds;
    bf16_t* Xb = (bf16_t*)(p.ws + WS_XB); bf16_t* H = (bf16_t*)(p.ws + WS_R1); bf16_t* CAT = (bf16_t*)(p.ws + WS_CAT); float* X = p.out;
    if (blockIdx.x == 0) { unsigned* bw = (unsigned*)(p.ws + WS_BAR); for (int i = threadIdx.x; i < XCD_BAR_WORDS; i += NT) bw[i] = 0u; }
    if (threadIdx.x < 4) ((volatile LAS unsigned*)(L + 131072))[threadIdx.x] = 0u;
    prep_phase(lds, p);
    grid.sync();
    const XcdBarrier xbar = xcd_barrier_post((unsigned*)(p.ws + WS_BAR), (volatile LAS unsigned*)(L + 131072));
#pragma unroll 1
    for (int l = 0; l < 4; ++l) {
        { const bf16_t* W = (const bf16_t*)(p.ws + WS_WIN) + (size_t)l * NIN * DM;
          pg8::StaticOrder S; S.init(TP, NIN, (int)gridDim.x, (int)blockIdx.x);
          pg8::gemm_phase<pg8::EpiB16<0>, pg8::StaticOrder>(L, pg8::Gemm{Xb, W, TP, NIN, DM}, S, pg8::EpiB16<0>{H, NIN}, nullptr);
          small_gemm<NIN, DM>(lds, Xb + (size_t)TP * DM, W, EpiH{H}); }
        xcd_barrier(xbar);
        mix_a_phase(lds, p, l);
        xcd_barrier(xbar);
        scan_phase(p, l);
        xcd_barrier(xbar);
        mix_c_phase(lds, p, l);
        xcd_barrier(xbar);
        { const bf16_t* W = (const bf16_t*)(p.ws + WS_WOUT) + (size_t)l * DM * DM;
          pg8::StaticOrder S; S.init(TP, DM, (int)gridDim.x, (int)blockIdx.x);
          pg8::gemm_phase<pg8::EpiResF32, pg8::StaticOrder>(L, pg8::Gemm{CAT, W, TP, DM, DM}, S, pg8::EpiResF32{X, DM, ALPHA}, nullptr);
          small_gemm<DM, DM>(lds, CAT + (size_t)TP * DM, W, EpiRes{X}); }
        xcd_barrier(xbar);
        ln_phase(X, Xb, p.ln_mix_g + l * DM, p.ln_mix_b + l * DM);
        xcd_barrier(xbar);
        { const bf16_t* W = (const bf16_t*)(p.ws + WS_WUP) + (size_t)l * DFF * DM;
          pg8::StaticOrder S; S.init(TP, DFF, (int)gridDim.x, (int)blockIdx.x);
          pg8::gemm_phase<pg8::EpiB16<1>, pg8::StaticOrder>(L, pg8::Gemm{Xb, W, TP, DFF, DM}, S, pg8::EpiB16<1>{H, DFF}, nullptr);
          small_gemm<DFF, DM>(lds, Xb + (size_t)TP * DM, W, EpiRelu2{H}); }
        xcd_barrier(xbar);
        { const bf16_t* W = (const bf16_t*)(p.ws + WS_WDN) + (size_t)l * DM * DFF;
          pg8::StaticOrder S; S.init(TP, DM, (int)gridDim.x, (int)blockIdx.x);
          pg8::gemm_phase<pg8::EpiResF32, pg8::StaticOrder>(L, pg8::Gemm{H, W, TP, DM, DFF}, S, pg8::EpiResF32{X, DM, ALPHA}, nullptr);
          small_gemm<DM, DFF>(lds, H + (size_t)TP * DFF, W, EpiRes{X}); }
        xcd_barrier(xbar);
        ln_phase(X, Xb, p.ln_ffn_g + l * DM, p.ln_ffn_b + l * DM);
        xcd_barrier(xbar);
    }
}

extern "C" void kernel_launch(void* const* d_in, const int* in_sizes, int n_in, void* d_out, int out_size, void* d_ws, size_t ws_size, hipStream_t stream) {
    static int grid_blocks = 0;
    if (!grid_blocks) {
        int dev = 0, cus = 0, per_cu = 0;
        hipGetDevice(&dev);
        hipDeviceGetAttribute(&cus, hipDeviceAttributeMultiprocessorCount, dev);
        hipFuncSetAttribute((const void*)fwd_megakernel, hipFuncAttributeMaxDynamicSharedMemorySize, LDS_BYTES);
        hipOccupancyMaxActiveBlocksPerMultiprocessor(&per_cu, (const void*)fwd_megakernel, NT, LDS_BYTES);
        if (per_cu < 1) per_cu = 1;
        grid_blocks = cus * per_cu;
        if (ws_size < WS_END) fprintf(stderr, "workspace too small: %zu < %zu\n", ws_size, (size_t)WS_END);
    }
    Params p{};
    p.x_prompt = (const float*)d_in[0]; p.x_sample = (const float*)d_in[1]; p.state_ret = (const float*)d_in[2]; p.state_hgrn = (const float*)d_in[3];
    p.cache_k = (const float*)d_in[4]; p.cache_v = (const float*)d_in[5]; p.w_in = (const float*)d_in[6]; p.w_out = (const float*)d_in[7];
    p.sinks = (const float*)d_in[8]; p.lb_raw = (const float*)d_in[9]; p.hg_norm_w = (const float*)d_in[10]; p.ln_mix_g = (const float*)d_in[11];
    p.ln_mix_b = (const float*)d_in[12]; p.w_up = (const float*)d_in[13]; p.w_down = (const float*)d_in[14]; p.ln_ffn_g = (const float*)d_in[15]; p.ln_ffn_b = (const float*)d_in[16];
    p.out = (float*)d_out; p.ws = (unsigned char*)d_ws;
    void* args[] = {&p};
    hipError_t e = hipLaunchCooperativeKernel((const void*)fwd_megakernel, dim3(grid_blocks), dim3(NT), args, LDS_BYTES, stream);
    if (e != hipSuccess) fprintf(stderr, "cooperative launch failed: %s (grid %d)\n", hipGetErrorString(e), grid_blocks);
}
```
